# Optimizing an MI355X kernel written in HIP

```python
import math
import jax, jax.numpy as jnp
from jax import lax
import numpy as np

D_MODEL = 1024
BATCH = 2
SEQ = 8192
DEPTH = 2

GRID_W = 64
CTX_LEN = 256
NORM_EPS = 1e-6

ATT_HEADS = 8
ATT_KV_HEADS = 2
HEAD_DIM = 64
ATT_WIDTH = ATT_HEADS * HEAD_DIM
KV_WIDTH = ATT_KV_HEADS * HEAD_DIM
ROPE_THETA = 10000.0
ROPE_FREQS = HEAD_DIM // 4
Q_BLOCK = 128

CONV_WIDTH = 512

POOL_WIDTH = 512
POOL_WINDOWS = (2, 4, 8, 16)
POOL_GROUP = POOL_WIDTH // 4

SSD_HEADS = 8
SSD_HEAD_DIM = 64
SSD_WIDTH = SSD_HEADS * SSD_HEAD_DIM
SSD_GROUPS = 2
SSD_STATE = 64
SSD_CHUNK = 128
SSD_CONV_CH = SSD_WIDTH + 2 * SSD_GROUPS * SSD_STATE
DT_MIN = 1e-3
DT_MAX = 1e-1

N_BRANCH = 4
BRANCH_WIDTH = 512

D_FF = 2816

IN_SPLITS = (ATT_WIDTH, KV_WIDTH, KV_WIDTH,
             CONV_WIDTH, CONV_WIDTH, CONV_WIDTH,
             POOL_WIDTH,
             SSD_WIDTH, SSD_CONV_CH, 2 * SSD_HEADS,
             N_BRANCH * D_MODEL)
IN_DIM = 768 + 1536 + 512 + 512 + 768 + 16 + 4096

kernel_name = "hybrid_parallel_gqa_conv_pool_ssd_adaln"

F32 = jnp.float32


def rms_norm(x, g):
    xf = x.astype(F32)
    y = xf * lax.rsqrt(jnp.mean(xf * xf, axis=-1, keepdims=True) + NORM_EPS)
    return (y * g.astype(F32)).astype(x.dtype)


def modulation(cond, w_mod, b_mod):
    m = jax.nn.silu(cond) @ w_mod + b_mod
    return jnp.split(m[..., None, :], 6, axis=-1)


def modulate(h, shift, scale):
    return h * (1 + scale) + shift


def conv3_centred(u, w):
    up = jnp.pad(u, ((0, 0), (1, 1), (0, 0)))
    return up[:, :-2] * w[0] + up[:, 1:-1] * w[1] + up[:, 2:] * w[2]


def split_in(proj):
    idx = [int(i) for i in np.cumsum(IN_SPLITS)[:-1]]
    return jnp.split(proj, idx, axis=-1)


def axial_rope_tables(n_tokens):
    rows = n_tokens // GRID_W
    row = jnp.repeat(jnp.arange(rows), GRID_W).astype(F32)
    col = jnp.tile(jnp.arange(GRID_W), rows).astype(F32)
    inv = ROPE_THETA ** (-jnp.arange(ROPE_FREQS, dtype=F32) / ROPE_FREQS)
    ang = jnp.stack([row[:, None] * inv, col[:, None] * inv], axis=1)
    return jnp.cos(ang), jnp.sin(ang)


def apply_axial_rope(t, cos, sin):
    b, n, h, d = t.shape
    tf = t.astype(F32).reshape(b, n, h, 2, 2, ROPE_FREQS)
    t1, t2 = tf[..., 0, :], tf[..., 1, :]
    cs, sn = cos[None, :, None], sin[None, :, None]
    out = jnp.stack([t1 * cs - t2 * sn, t1 * sn + t2 * cs], axis=-2)
    return out.reshape(b, n, h, d).astype(t.dtype)


def split_heads(t, n_heads):
    return t.reshape(t.shape[0], t.shape[1], n_heads, HEAD_DIM)


def gqa_attend(q, k, v):
    b, nq, h, dh = q.shape
    g = k.shape[2]
    qg = q.reshape(b, nq, g, h // g, dh)
    s = jnp.einsum('bqgrd,bkgd->bgrqk', qg, k).astype(F32) * (dh ** -0.5)
    p = jax.nn.softmax(s, axis=-1).astype(v.dtype)
    o = jnp.einsum('bgrqk,bkgd->bqgrd', p, v)
    return o.reshape(b, nq, h, dh)


def attention_branch(q, k, v, qc, kc, vc, q_norm, k_norm, with_ctx_out):
    b, n, _ = q.shape
    cos, sin = axial_rope_tables(n)
    q = apply_axial_rope(rms_norm(split_heads(q, ATT_HEADS), q_norm), cos, sin)
    k = apply_axial_rope(rms_norm(split_heads(k, ATT_KV_HEADS), k_norm), cos, sin)
    v = split_heads(v, ATT_KV_HEADS)
    kc = rms_norm(split_heads(kc, ATT_KV_HEADS), k_norm)
    vc = split_heads(vc, ATT_KV_HEADS)
    keys = jnp.concatenate([kc, k], axis=1)
    vals = jnp.concatenate([vc, v], axis=1)
    qb = q.reshape(b, n // Q_BLOCK, Q_BLOCK, ATT_HEADS, HEAD_DIM).transpose(1, 0, 2, 3, 4)
    out = lax.map(lambda blk: gqa_attend(blk, keys, vals), qb)
    out = out.transpose(1, 0, 2, 3, 4).reshape(b, n, ATT_WIDTH)
    out_c = None
    if with_ctx_out:
        qch = rms_norm(split_heads(qc, ATT_HEADS), q_norm)
        out_c = gqa_attend(qch, kc, vc).reshape(b, qc.shape[1], ATT_WIDTH)
    return out, out_c


def short_conv_branch(b_gate, c_gate, u, w_conv):
    return b_gate * conv3_centred(c_gate * u, w_conv)


def centred_pool_minus_self(u, window):
    n = u.shape[1]
    uf = u.astype(F32)
    cs = jnp.pad(jnp.cumsum(uf, axis=1), ((0, 0), (1, 0), (0, 0)))
    t = jnp.arange(n)
    lo = jnp.clip(t - window // 2, 0, n)
    hi = jnp.clip(t + window // 2, 0, n)
    mean = (cs[:, hi] - cs[:, lo]) / (hi - lo).astype(F32)[None, :, None]
    return (mean - uf).astype(u.dtype)


def pool_branch(u, w_pool, pool_scale):
    b, n, _ = u.shape
    groups = jnp.split(u, len(POOL_WINDOWS), axis=-1)
    pooled = jnp.stack([centred_pool_minus_self(g, w) for g, w in zip(groups, POOL_WINDOWS)], axis=-2)
    mixed = jnp.einsum('blgc,gcd->blgd', pooled, w_pool).reshape(b, n, POOL_WIDTH)
    return mixed * pool_scale


def segsum(a):
    t = a.shape[-1]
    rep = jnp.broadcast_to(a[..., :, None], a.shape + (t,))
    rep = jnp.where(jnp.tril(jnp.ones((t, t), bool), -1), rep, 0.0)
    s = jnp.cumsum(rep, axis=-2)
    return jnp.where(jnp.tril(jnp.ones((t, t), bool), 0), s, -jnp.inf)


def ssd_scan(x, dt, a_rate, bm, cm, h0):
    b, l, nh, p = x.shape
    g, n = bm.shape[2], bm.shape[3]
    r = nh // g
    nc, tt = l // SSD_CHUNK, SSD_CHUNK
    xdt = (x.astype(F32) * dt[..., None]).reshape(b, nc, tt, g, r, p)
    bc = bm.astype(F32).reshape(b, nc, tt, g, n)
    cc = cm.astype(F32).reshape(b, nc, tt, g, n)
    a = (dt * a_rate).reshape(b, nc, tt, g, r).transpose(0, 1, 3, 4, 2)
    a_cum = jnp.cumsum(a, axis=-1)
    cb = jnp.einsum('bclgn,bcsgn->bcgls', cc, bc)
    w = cb[:, :, :, None] * jnp.exp(segsum(a))
    y_diag = jnp.einsum('bcgrls,bcsgrp->bclgrp', w, xdt)
    decay_to_end = jnp.exp(a_cum[..., -1:] - a_cum)
    states = jnp.einsum('bcsgn,bcgrs,bcsgrp->bcgrpn', bc, decay_to_end, xdt)
    chunk_decay = jnp.exp(a_cum[..., -1])

    def step(h, inp):
        st, dec = inp
        return h * dec[..., None, None] + st, h

    h_final, h_prev = lax.scan(step, h0.reshape(b, g, r, p, n),
                               (jnp.moveaxis(states, 1, 0), jnp.moveaxis(chunk_decay, 1, 0)))
    h_prev = jnp.moveaxis(h_prev, 0, 1)
    y_off = jnp.einsum('bclgn,bcgrpn,bcgrl->bclgrp', cc, h_prev, jnp.exp(a_cum))
    y = (y_diag + y_off).reshape(b, l, nh, p)
    return y.astype(x.dtype), h_final.reshape(b, nh, p, n)


def ssd_prep(xbc, dt_raw, conv_w, conv_b, dt_bias):
    b, l, _ = xbc.shape
    xbc = jax.nn.silu(conv3_centred(xbc, conv_w) + conv_b)
    xs, bm, cm = jnp.split(xbc, [SSD_WIDTH, SSD_WIDTH + SSD_GROUPS * SSD_STATE], axis=-1)
    xs = xs.reshape(b, l, SSD_HEADS, SSD_HEAD_DIM)
    bm = bm.reshape(b, l, SSD_GROUPS, SSD_STATE)
    cm = cm.reshape(b, l, SSD_GROUPS, SSD_STATE)
    dt = jax.nn.softplus(dt_raw.astype(F32).reshape(b, l, 2, SSD_HEADS) + dt_bias.astype(F32))
    return xs, bm, cm, dt


def ssd_branch(z, xbc, dt_raw, zc, xbcc, dtc_raw, conv_w, conv_b, dt_bias, a_log, d_skip, norm_g,
               with_ctx_out):
    xs, bm, cm, dt = ssd_prep(xbc, dt_raw, conv_w, conv_b, dt_bias)
    xs_c, bm_c, cm_c, dt_c = ssd_prep(xbcc, dtc_raw, conv_w, conv_b, dt_bias)
    a_rate = -jnp.exp(a_log.astype(F32))
    b = xs.shape[0]
    y = d_skip[:, None] * xs
    y_c = d_skip[:, None] * xs_c
    for d, flip in enumerate((False, True)):
        f = (lambda t: jnp.flip(t, axis=1)) if flip else (lambda t: t)
        h0 = jnp.zeros((b, SSD_HEADS, SSD_HEAD_DIM, SSD_STATE), F32)
        yd_c, h_ctx = ssd_scan(f(xs_c), f(dt_c[:, :, d]), a_rate[d], f(bm_c), f(cm_c), h0)
        yd, _ = ssd_scan(f(xs), f(dt[:, :, d]), a_rate[d], f(bm), f(cm), h_ctx)
        y = y + f(yd)
        y_c = y_c + f(yd_c)
    out = rms_norm(y.reshape(z.shape) * jax.nn.silu(z), norm_g)
    out_c = rms_norm(y_c.reshape(zc.shape) * jax.nn.silu(zc), norm_g) if with_ctx_out else None
    return out, out_c


def merge_branches(branches, gate_logits, w_branch):
    b, n, _ = gate_logits.shape
    gates = jax.nn.sigmoid(gate_logits.astype(F32)).astype(gate_logits.dtype).reshape(b, n, N_BRANCH, D_MODEL)
    proj = jnp.einsum('blkc,kcd->blkd', jnp.stack(branches, axis=-2), w_branch)
    return jnp.sum(gates * proj, axis=-2)


def mixing_sublayer(h, hc, w_in, q_norm, k_norm, conv_short, pool_w, pool_scale,
                    ssd_conv_w, ssd_conv_b, ssd_dt_bias, ssd_a_log, ssd_d, ssd_norm,
                    w_branch, w_out, with_ctx_out):
    q, k, v, bg, cg, u, pu, z, xbc, dt, gl = split_in(h @ w_in)
    qc, kc, vc, bgc, cgc, uc, puc, zc, xbcc, dtc, glc = split_in(hc @ w_in)
    att, att_c = attention_branch(q, k, v, qc, kc, vc, q_norm, k_norm, with_ctx_out)
    ssd, ssd_c = ssd_branch(z, xbc, dt, zc, xbcc, dtc, ssd_conv_w, ssd_conv_b, ssd_dt_bias,
                            ssd_a_log, ssd_d, ssd_norm, with_ctx_out)
    y = merge_branches((att, short_conv_branch(bg, cg, u, conv_short),
                        pool_branch(pu, pool_w, pool_scale), ssd), gl, w_branch) @ w_out
    if not with_ctx_out:
        return y, None
    yc = merge_branches((att_c, short_conv_branch(bgc, cgc, uc, conv_short),
                         pool_branch(puc, pool_w, pool_scale), ssd_c), glc, w_branch) @ w_out
    return y, yc


def conv_ffn(h, w_up, w_conv, w_down):
    up = conv3_centred(h @ w_up, w_conv)
    g, v = jnp.split(up, 2, axis=-1)
    return (jax.nn.silu(g) * v) @ w_down


def setup_inputs(seed: int = 0) -> dict:
    key = jax.random.key(seed)
    ks = iter(jax.random.split(key, 40))

    def nrm(shape, scale):
        return jax.random.normal(next(ks), shape, F32) * scale

    def gain(shape):
        return 1.0 + 0.02 * jax.random.normal(next(ks), shape, F32)

    u = jax.random.uniform(next(ks), (DEPTH, 2, SSD_HEADS), F32)
    dt0 = jnp.exp(u * (math.log(DT_MAX) - math.log(DT_MIN)) + math.log(DT_MIN))
    ssd_dt_bias = dt0 + jnp.log(-jnp.expm1(-dt0))
    ssd_a_log = jnp.log(jax.random.uniform(next(ks), (DEPTH, 2, SSD_HEADS), F32, 1.0, 16.0))
    return {
        "x": nrm((BATCH, SEQ, D_MODEL), 1.0),
        "c": nrm((BATCH, D_MODEL), 1.0),
        "ctx": nrm((BATCH, CTX_LEN, D_MODEL), 1.0),
        "c_ctx": nrm((D_MODEL,), 1.0),
        "w_mod": nrm((DEPTH, D_MODEL, 6 * D_MODEL), 0.5 * D_MODEL ** -0.5),
        "b_mod": nrm((DEPTH, 6 * D_MODEL), 0.02),
        "norm_mix": gain((DEPTH, D_MODEL)),
        "w_in": nrm((DEPTH, D_MODEL, IN_DIM), D_MODEL ** -0.5),
        "q_norm": gain((DEPTH, HEAD_DIM)),
        "k_norm": gain((DEPTH, HEAD_DIM)),
        "conv_short": nrm((DEPTH, 3, CONV_WIDTH), 3 ** -0.5),
        "pool_w": nrm((DEPTH, len(POOL_WINDOWS), POOL_GROUP, POOL_GROUP), POOL_GROUP ** -0.5),
        "pool_scale": 1.0 + 0.1 * jax.random.normal(next(ks), (DEPTH, POOL_WIDTH), F32),
        "ssd_conv_w": nrm((DEPTH, 3, SSD_CONV_CH), 3 ** -0.5),
        "ssd_conv_b": nrm((DEPTH, SSD_CONV_CH), 0.02),
        "ssd_dt_bias": ssd_dt_bias,
        "ssd_a_log": ssd_a_log,
        "ssd_d": gain((DEPTH, SSD_HEADS)),
        "ssd_norm": gain((DEPTH, SSD_WIDTH)),
        "w_branch": nrm((DEPTH, N_BRANCH, BRANCH_WIDTH, D_MODEL), BRANCH_WIDTH ** -0.5),
        "w_out": nrm((DEPTH, D_MODEL, D_MODEL), D_MODEL ** -0.5),
        "norm_ffn": gain((DEPTH, D_MODEL)),
        "w_up": nrm((DEPTH, D_MODEL, 2 * D_FF), D_MODEL ** -0.5),
        "ffn_conv": nrm((DEPTH, 3, 2 * D_FF), 3 ** -0.5),
        "w_down": nrm((DEPTH, D_FF, D_MODEL), D_FF ** -0.5),
        "final_norm": gain((D_MODEL,)),
    }


def reference(x, c, ctx, c_ctx, w_mod, b_mod, norm_mix, w_in, q_norm, k_norm, conv_short,
              pool_w, pool_scale, ssd_conv_w, ssd_conv_b, ssd_dt_bias, ssd_a_log, ssd_d,
              ssd_norm, w_branch, w_out, norm_ffn, w_up, ffn_conv, w_down, final_norm):
    xc = ctx
    for i in range(DEPTH):
        with_ctx_out = i < DEPTH - 1
        sh1, sc1, g1, sh2, sc2, g2 = modulation(c, w_mod[i], b_mod[i])
        csh1, csc1, cg1, csh2, csc2, cg2 = modulation(c_ctx, w_mod[i], b_mod[i])
        h = modulate(rms_norm(x, norm_mix[i]), sh1, sc1)
        hc = modulate(rms_norm(xc, norm_mix[i]), csh1, csc1)
        y, yc = mixing_sublayer(h, hc, w_in[i], q_norm[i], k_norm[i], conv_short[i], pool_w[i],
                                pool_scale[i], ssd_conv_w[i], ssd_conv_b[i], ssd_dt_bias[i],
                                ssd_a_log[i], ssd_d[i], ssd_norm[i], w_branch[i], w_out[i],
                                with_ctx_out)
        x = x + g1 * y
        h = modulate(rms_norm(x, norm_ffn[i]), sh2, sc2)
        x = x + g2 * conv_ffn(h, w_up[i], ffn_conv[i], w_down[i])
        if with_ctx_out:
            xc = xc + cg1 * yc
            hc = modulate(rms_norm(xc, norm_ffn[i]), csh2, csc2)
            xc = xc + cg2 * conv_ffn(hc, w_up[i], ffn_conv[i], w_down[i])
    return rms_norm(x, final_norm)
```

```cpp
#include <hip/hip_runtime.h>
#include <hip/hip_cooperative_groups.h>
#include <stdint.h>
#include <stdio.h>
namespace cg = cooperative_groups;

typedef unsigned short u16;
typedef __attribute__((ext_vector_type(8))) short bf16x8;
typedef __attribute__((ext_vector_type(16))) float f32x16;
typedef __bf16 bf16x2_t __attribute__((ext_vector_type(2)));
typedef float f2_t __attribute__((ext_vector_type(2)));

#define DEV __device__ __forceinline__

constexpr int R = 16896;
constexpr int RB = 8448;
constexpr int PW = 4096;
constexpr int C_Q = 0, C_K = 512, C_BG = 768, C_CG = 1280, C_U = 1792, C_PU = 2304, C_Z = 2816, C_XS = 3328, C_BM = 3840, C_CM = 3968;
constexpr int C_YM = 1280;
constexpr int NTHR = 256;
constexpr int SMEM_BYTES = 77824;

constexpr size_t OFF_WT_IN = 0;
constexpr size_t OFF_WT_BR = OFF_WT_IN + (size_t)8208 * 1024 * 2;
constexpr size_t OFF_WT_OUT = OFF_WT_BR + (size_t)4 * 1024 * 512 * 2;
constexpr size_t OFF_WT_UP = OFF_WT_OUT + (size_t)1024 * 1024 * 2;
constexpr size_t OFF_WT_DOWN = OFF_WT_UP + (size_t)5632 * 1024 * 2;
constexpr size_t OFF_H = OFF_WT_DOWN + (size_t)1024 * 2816 * 2;
constexpr size_t OFF_P = OFF_H + (size_t)R * 1024 * 2;
constexpr size_t OFF_VT = OFF_P + (size_t)R * PW * 2;
constexpr size_t OFF_POOLED = OFF_VT + (size_t)4 * 64 * RB * 2;
constexpr size_t OFF_S = OFF_POOLED + (size_t)R * 512 * 2;
constexpr size_t OFF_XC = OFF_S + (size_t)32 * 66 * 4096 * 4;
constexpr size_t OFF_DT = OFF_XC + (size_t)512 * 1024 * 4;
constexpr size_t OFF_SSQ = OFF_DT + (size_t)R * 16 * 4;
constexpr size_t OFF_DECAY = OFF_SSQ + (size_t)R * 8 * 4;
constexpr size_t OFF_MOD = OFF_DECAY + (size_t)32 * 66 * 4 + 256;
constexpr size_t OFF_ROPE = OFF_MOD + (size_t)2 * 3 * 6144 * 4;
constexpr size_t OFF_BAR = OFF_ROPE + (size_t)2 * 128 * 16 * 4;
constexpr size_t WS_NEEDED = OFF_BAR + 3456 * 4;

struct Params {
  const float *x, *c, *ctx, *c_ctx, *w_mod, *b_mod, *norm_mix, *w_in, *q_norm, *k_norm, *conv_short, *pool_w, *pool_scale,
      *ssd_conv_w, *ssd_conv_b, *ssd_dt_bias, *ssd_a_log, *ssd_d, *ssd_norm, *w_branch, *w_out, *norm_ffn, *w_up, *ffn_conv,
      *w_down, *final_norm;
  float* out;
  char* ws;
  int phase_lo, phase_hi;
};

DEV int tid() { int t = __builtin_amdgcn_workitem_id_x(); asm volatile("" : "+v"(t)); return t; }
DEV int bid() { int b = __builtin_amdgcn_workgroup_id_x(); asm volatile("" : "+s"(b)); return b; }
DEV unsigned pack2(float a, float b) {
  f2_t v = {a, b};
  bf16x2_t r = __builtin_convertvector(v, bf16x2_t);
  return *(unsigned*)&r;
}
DEV u16 f2bf(float a) { return (u16)(pack2(a, 0.f) & 0xffff); }
DEV float bf2f(u16 h) { return __uint_as_float(((unsigned)h) << 16); }
DEV float bflo(unsigned u) { return __uint_as_float(u << 16); }
DEV float bfhi(unsigned u) { return __uint_as_float(u & 0xffff0000u); }
DEV float silu_f(float v) { return v * __builtin_amdgcn_rcpf(1.f + __expf(-v)); }
DEV float sigmoid_f(float v) { return __builtin_amdgcn_rcpf(1.f + __expf(-v)); }
DEV void unpack8(uint4 u, float* f) {
  f[0] = bflo(u.x); f[1] = bfhi(u.x); f[2] = bflo(u.y); f[3] = bfhi(u.y);
  f[4] = bflo(u.z); f[5] = bfhi(u.z); f[6] = bflo(u.w); f[7] = bfhi(u.w);
}
DEV uint4 pack8(const float* f) {
  uint4 u; u.x = pack2(f[0], f[1]); u.y = pack2(f[2], f[3]); u.z = pack2(f[4], f[5]); u.w = pack2(f[6], f[7]);
  return u;
}
DEV bf16x8 as_bf16x8(uint4 u) { union { uint4 a; bf16x8 b; } x; x.a = u; return x.b; }
DEV f32x16 mfma32(bf16x8 a, bf16x8 b, f32x16 c) { return __builtin_amdgcn_mfma_f32_32x32x16_bf16(a, b, c, 0, 0, 0); }
DEV int rowmap(int reg, int h) { return (reg & 3) + 8 * (reg >> 2) + 4 * h; }

DEV const float* xin_row(const Params& p, int r) {
  int b = r / RB, rr = r - b * RB;
  return rr < 256 ? p.ctx + ((size_t)(b * 256 + rr)) * 1024 : p.x + ((size_t)(b * 8192 + rr - 256)) * 1024;
}
DEV float* xres_row(const Params& p, int r) {
  int b = r / RB, rr = r - b * RB;
  return rr < 256 ? (float*)(p.ws + OFF_XC) + ((size_t)(b * 256 + rr)) * 1024 : p.out + ((size_t)(b * 8192 + rr - 256)) * 1024;
}
DEV int cond_of_row(int r) { int b = r / RB; return (r - b * RB) < 256 ? 2 : b; }

DEV bool tile_map(int j, int x, int Mt, int Nt, int& mt, int& nt) {
  int Mx = (Mt - x + 7) >> 3;
  int total = Mx * Nt;
  if (j >= total) return false;
  int full = Nt >> 3, per_full = Mx * 8;
  int mi, n;
  if (j < full * per_full) { int c = j / per_full; int rem = j - c * per_full; mi = rem >> 3; n = c * 8 + (rem & 7); }
  else { int rem = j - full * per_full; int wl = Nt - full * 8; mi = rem / wl; n = full * 8 + (rem - mi * wl); }
  mt = x + 8 * mi; nt = n;
  return true;
}

#define LAS3 __attribute__((address_space(3)))
template <int MI, int NI>
DEV void gemm_core(const u16* __restrict__ A, int lda, int arow0, int amax, const u16* __restrict__ Bt, int ldb, int brow0,
                   int brow1, int K, f32x16 (&acc)[MI][NI], char* smem) {
  const int t = tid(), lane = t & 63, w = t >> 6, wr = w >> 1, wc = w & 1, r = lane & 31, h = lane >> 5;
  constexpr int ASB = 4096 * MI, STB = 4096 * (MI + NI);
  const int lrow = lane >> 2, lp = lane & 3;
  unsigned oa[MI], ob[NI];
#pragma unroll
  for (int i = 0; i < MI; ++i) {
    int R_ = (w * MI + i) * 16 + lrow;
    int ar_ = arow0 + R_; ar_ = ar_ < 0 ? 0 : (ar_ > amax ? amax : ar_);
    oa[i] = (unsigned)ar_ * (unsigned)lda + (unsigned)((lp ^ ((R_ >> 2) & 3)) * 8);
  }
#pragma unroll
  for (int i = 0; i < NI; ++i) {
    int R_ = (w * NI + i) * 16 + lrow;
    int br_ = R_ < 64 ? brow0 + R_ : brow1 + R_ - 64;
    ob[i] = (unsigned)br_ * (unsigned)ldb + (unsigned)((lp ^ ((R_ >> 2) & 3)) * 8);
  }
  const int wu = __builtin_amdgcn_readfirstlane(w);
  char* sA_w = smem + wu * (1024 * MI);
  char* sB_w = smem + ASB + wu * (1024 * NI);
#pragma unroll
  for (int i = 0; i < MI; ++i) oa[i] *= 2u;
#pragma unroll
  for (int i = 0; i < NI; ++i) ob[i] *= 2u;
#define GLDS(stg, k0)                                                                                                    \
  {                                                                                                                      \
    char* da_ = sA_w + (stg) * STB;                                                                                      \
    char* db_ = sB_w + (stg) * STB;                                                                                      \
    const char* ga_ = (const char*)(A + (k0));                                                                           \
    const char* gb_ = (const char*)(Bt + (k0));                                                                          \
    _Pragma("unroll") for (int i = 0; i < MI; ++i)                                                                       \
        __builtin_amdgcn_global_load_lds((const void*)(ga_ + oa[i]), (LAS3 void*)(da_ + i * 1024), 16, 0, 0);            \
    _Pragma("unroll") for (int i = 0; i < NI; ++i)                                                                       \
        __builtin_amdgcn_global_load_lds((const void*)(gb_ + ob[i]), (LAS3 void*)(db_ + i * 1024), 16, 0, 0);            \
  }
  const int sw = (r >> 2) & 3;
  const int co0 = ((0 + h) ^ sw) << 4, co1 = ((2 + h) ^ sw) << 4;
  const int arow_b = (wr * 32 * MI + r) * 64;
  const int brow_b = ASB + (wc * 32 * NI + r) * 64;
  const int nk = K >> 5;
  GLDS(0, 0);
  GLDS(1, 32);
  int st = 0;
  for (int kt = 0; kt < nk; ++kt) {
    if (kt + 1 < nk) {
      if (MI + NI == 6) asm volatile("s_waitcnt vmcnt(6)" ::: "memory");
      else if (MI + NI == 4) asm volatile("s_waitcnt vmcnt(4)" ::: "memory");
      else asm volatile("s_waitcnt vmcnt(3)" ::: "memory");
    } else {
      asm volatile("s_waitcnt vmcnt(0)" ::: "memory");
    }
    __builtin_amdgcn_s_barrier();
    asm volatile("" ::: "memory");
    if (kt + 2 < nk) {
      int s2 = st + 2; s2 = s2 >= 3 ? s2 - 3 : s2;
      GLDS(s2, (kt + 2) << 5);
    }
    const char* cur = smem + st * STB;
#pragma unroll
    for (int ks = 0; ks < 2; ++ks) {
      const int co = ks == 0 ? co0 : co1;
      bf16x8 fb[NI];
#pragma unroll
      for (int ni = 0; ni < NI; ++ni) fb[ni] = *(const bf16x8*)(cur + brow_b + ni * 2048 + co);
#pragma unroll
      for (int mi = 0; mi < MI; ++mi) {
        bf16x8 fa = *(const bf16x8*)(cur + arow_b + mi * 2048 + co);
#pragma unroll
        for (int ni = 0; ni < NI; ++ni) acc[mi][ni] = mfma32(fa, fb[ni], acc[mi][ni]);
      }
    }
    st = st == 2 ? 0 : st + 1;
  }
  __syncthreads();
#undef GLDS
}

template <int MI, int NI>
DEV void zero_accm(f32x16 (&acc)[MI][NI]) {
#pragma unroll
  for (int a = 0; a < MI; ++a)
#pragma unroll
    for (int b = 0; b < NI; ++b)
#pragma unroll
      for (int i = 0; i < 16; ++i) acc[a][b][i] = 0.f;
}
template <int NI>
DEV void zero_acc(f32x16 (&acc)[2][NI]) { zero_accm<2, NI>(acc); }

DEV void mod_item(const Params& p, int item, char* smem) {
  int layer = item / 192, cgp = item - layer * 192;
  int t = tid(), kq = t >> 3, cq = t & 7;
  float* ssil = (float*)smem;
  float* red = ssil + 3 * 1024;
#pragma unroll
  for (int i = t; i < 3072; i += NTHR) {
    int a = i >> 10, k = i & 1023;
    float cv = a == 0 ? p.c[k] : (a == 1 ? p.c[1024 + k] : p.c_ctx[k]);
    ssil[i] = silu_f(cv);
  }
  __syncthreads();
  int col = cgp * 32 + cq * 4;
  const float* W = p.w_mod + (size_t)layer * 1024 * 6144 + col;
  float acc[3][4];
#pragma unroll
  for (int a = 0; a < 3; ++a)
#pragma unroll
    for (int b = 0; b < 4; ++b) acc[a][b] = 0.f;
#pragma unroll 1
  for (int k0 = kq * 32; k0 < kq * 32 + 32; k0 += 8) {
    float4 wv[8];
#pragma unroll
    for (int j = 0; j < 8; ++j) wv[j] = *(const float4*)(W + (size_t)(k0 + j) * 6144);
#pragma unroll
    for (int j = 0; j < 8; ++j) {
#pragma unroll
      for (int a = 0; a < 3; ++a) {
        float sv = ssil[a * 1024 + k0 + j];
        acc[a][0] += sv * wv[j].x; acc[a][1] += sv * wv[j].y; acc[a][2] += sv * wv[j].z; acc[a][3] += sv * wv[j].w;
      }
    }
  }
#pragma unroll
  for (int a = 0; a < 3; ++a)
#pragma unroll
    for (int b = 0; b < 4; ++b) red[(kq * 3 + a) * 32 + cq * 4 + b] = acc[a][b];
  __syncthreads();
  if (t < 96) {
    int a = t >> 5, cc = t & 31;
    float sum = 0.f;
    for (int q = 0; q < 32; ++q) sum += red[(q * 3 + a) * 32 + cc];
    int cg = cgp * 32 + cc;
    float* mod = (float*)(p.ws + OFF_MOD);
    mod[(layer * 3 + a) * 6144 + cg] = sum + p.b_mod[layer * 6144 + cg];
  }
  __syncthreads();
}

DEV void convT_tile(const float* __restrict__ src, int K, int N, u16* __restrict__ dst, int ldd, const float* __restrict__ kscale,
                    int tk, int tn, char* smem) {
  float* tile = (float*)smem;
  int t = tid();
  int n4 = (t & 15) * 4, kk = t >> 4;
  float4 v[4];
#pragma unroll
  for (int i = 0; i < 4; ++i) {
    int gn = tn * 64 + n4, gk = tk * 64 + kk + 16 * i;
    v[i] = gn < N ? *(const float4*)(src + (size_t)gk * N + gn) : make_float4(0.f, 0.f, 0.f, 0.f);
  }
#pragma unroll
  for (int i = 0; i < 4; ++i) {
    int k = kk + 16 * i;
    float sc = kscale ? kscale[tk * 64 + k] : 1.f;
    tile[k * 65 + n4] = v[i].x * sc; tile[k * 65 + n4 + 1] = v[i].y * sc;
    tile[k * 65 + n4 + 2] = v[i].z * sc; tile[k * 65 + n4 + 3] = v[i].w * sc;
  }
  __syncthreads();
  int wn = t >> 2, ks = (t & 3) * 16;
  int gn = tn * 64 + wn;
  if (gn < N) {
    float f[16];
#pragma unroll
    for (int i = 0; i < 16; ++i) f[i] = tile[(ks + i) * 65 + wn];
    uint4 u0 = pack8(f), u1 = pack8(f + 8);
    u16* d = dst + (size_t)gn * ldd + tk * 64 + ks;
    *(uint4*)d = u0;
    *(uint4*)(d + 8) = u1;
  }
  __syncthreads();
}

DEV void poolfold_item(const Params& p, int layer, int item, char* smem) {
  int g = item >> 6, nt = (item >> 2) & 15, cq = item & 3;
  int t = tid(), nl = t & 63, jq = t >> 6, n = nt * 64 + nl;
  float* sWp = (float*)smem;
  float* red = sWp + 32 * 128;
  const float* Wp = p.pool_w + ((size_t)(layer * 4 + g)) * 128 * 128 + (size_t)cq * 32 * 128;
  for (int i = t; i < 1024; i += NTHR) *(float4*)(sWp + i * 4) = *(const float4*)(Wp + i * 4);
  __syncthreads();
  const float* Wb = p.w_branch + ((size_t)(layer * 4 + 2)) * 512 * 1024 + (size_t)(g * 128 + jq * 32) * 1024 + n;
  const float* sc = p.pool_scale + layer * 512 + g * 128 + jq * 32;
  float wb[32];
#pragma unroll
  for (int j = 0; j < 32; ++j) wb[j] = Wb[(size_t)j * 1024] * sc[j];
  float acc[32];
#pragma unroll
  for (int i = 0; i < 32; ++i) {
    float a = 0.f;
#pragma unroll
    for (int j4 = 0; j4 < 8; ++j4) {
      float4 w4 = *(const float4*)(sWp + i * 128 + jq * 32 + j4 * 4);
      a += w4.x * wb[j4 * 4] + w4.y * wb[j4 * 4 + 1] + w4.z * wb[j4 * 4 + 2] + w4.w * wb[j4 * 4 + 3];
    }
    acc[i] = a;
  }
#pragma unroll
  for (int i = 0; i < 32; ++i) red[(jq * 32 + i) * 64 + nl] = acc[i];
  __syncthreads();
  {
    int on = t >> 2, c0 = (t & 3) * 8;
    float v[8];
#pragma unroll
    for (int i = 0; i < 8; ++i)
      v[i] = red[(0 * 32 + c0 + i) * 64 + on] + red[(1 * 32 + c0 + i) * 64 + on] + red[(2 * 32 + c0 + i) * 64 + on] + red[(3 * 32 + c0 + i) * 64 + on];
    u16* dst = (u16*)(p.ws + OFF_WT_BR) + (size_t)2 * 1024 * 512 + (size_t)(nt * 64 + on) * 512 + g * 128 + cq * 32 + c0;
    *(uint4*)dst = pack8(v);
  }
  __syncthreads();
}

DEV void convert_weights(const Params& p, int layer, int part, char* smem) {
  const int n_in = 16 * 129, n_br = 3 * 8 * 16, n_out = 16 * 16, n_up = 16 * 88, n_dn = 44 * 16, n_pf = 256;
  const int total = n_in + n_br + n_out + n_up + n_dn + n_pf;
  const int it0 = part == 0 ? 0 : n_in, it1 = part == 0 ? n_in : total;
  for (int it = it0 + bid(); it < it1; it += gridDim.x) {
    int i = it;
    if (i < n_in) {
      convT_tile(p.w_in + (size_t)layer * 1024 * 8208, 1024, 8208, (u16*)(p.ws + OFF_WT_IN), 1024, nullptr, i & 15, i >> 4, smem);
      continue;
    }
    i -= n_in;
    if (i < n_br) {
      int kb = i / 128, rem = i - kb * 128;
      int br = kb == 2 ? 3 : kb;
      convT_tile(p.w_branch + ((size_t)(layer * 4 + br)) * 512 * 1024, 512, 1024,
                 (u16*)(p.ws + OFF_WT_BR) + (size_t)br * 1024 * 512, 512, br == 3 ? p.ssd_norm + layer * 512 : nullptr, rem & 7,
                 rem >> 3, smem);
      continue;
    }
    i -= n_br;
    if (i < n_out) {
      convT_tile(p.w_out + (size_t)layer * 1024 * 1024, 1024, 1024, (u16*)(p.ws + OFF_WT_OUT), 1024, nullptr, i & 15, i >> 4, smem);
      continue;
    }
    i -= n_out;
    if (i < n_up) {
      convT_tile(p.w_up + (size_t)layer * 1024 * 5632, 1024, 5632, (u16*)(p.ws + OFF_WT_UP), 1024, nullptr, i & 15, i >> 4, smem);
      continue;
    }
    i -= n_up;
    if (i < n_dn) {
      convT_tile(p.w_down + (size_t)layer * 2816 * 1024, 2816, 1024, (u16*)(p.ws + OFF_WT_DOWN), 2816, nullptr, i % 44, i / 44, smem);
      continue;
    }
    i -= n_dn;
    poolfold_item(p, layer, i, smem);
  }
}

DEV void norm_phase(const Params& p, int layer, int which, bool from_input) {
  const int lane = tid() & 63, w = tid() >> 6;
  const float* mod = (const float*)(p.ws + OFF_MOD);
  u16* H = (u16*)(p.ws + OFF_H);
  const int gw = bid() * 4 + w, nw = gridDim.x * 4;
  const float* gn = which == 2 ? p.final_norm : (which == 0 ? p.norm_mix : p.norm_ffn) + layer * 1024;
  float4 g4[4];
#pragma unroll
  for (int i = 0; i < 4; ++i) g4[i] = *(const float4*)(gn + i * 256 + lane * 4);
  for (int r0 = gw; r0 < R; r0 += 4 * nw) {
    int rws[4] = {r0, r0 + nw, r0 + 2 * nw, r0 + 3 * nw};
    float4 v[4][4];
    bool ok[4];
#pragma unroll
    for (int q = 0; q < 4; ++q) {
      int r = rws[q];
      int b = r / RB, rr = r - b * RB;
      ok[q] = r < R && !(which == 2 && rr < 256);
      if (ok[q]) {
        const float* xr = from_input ? xin_row(p, r) : xres_row(p, r);
#pragma unroll
        for (int i = 0; i < 4; ++i) v[q][i] = *(const float4*)(xr + i * 256 + lane * 4);
      } else {
#pragma unroll
        for (int i = 0; i < 4; ++i) v[q][i] = make_float4(0.f, 0.f, 0.f, 0.f);
      }
    }
    float ss[4];
#pragma unroll
    for (int q = 0; q < 4; ++q) {
      ss[q] = 0.f;
#pragma unroll
      for (int i = 0; i < 4; ++i) ss[q] += v[q][i].x * v[q][i].x + v[q][i].y * v[q][i].y + v[q][i].z * v[q][i].z + v[q][i].w * v[q][i].w;
    }
#pragma unroll
    for (int o = 32; o >= 1; o >>= 1) { ss[0] += __shfl_xor(ss[0], o); ss[1] += __shfl_xor(ss[1], o); ss[2] += __shfl_xor(ss[2], o); ss[3] += __shfl_xor(ss[3], o); }
#pragma unroll
    for (int q = 0; q < 4; ++q) {
      if (!ok[q]) continue;
      int r = rws[q];
      int b = r / RB, rr = r - b * RB;
      float rstd = rsqrtf(ss[q] * (1.f / 1024.f) + 1e-6f);
      if (which == 2) {
        float* o = p.out + ((size_t)(b * 8192 + rr - 256)) * 1024;
#pragma unroll
        for (int i = 0; i < 4; ++i) {
          float4 y; y.x = v[q][i].x * rstd * g4[i].x; y.y = v[q][i].y * rstd * g4[i].y; y.z = v[q][i].z * rstd * g4[i].z; y.w = v[q][i].w * rstd * g4[i].w;
          *(float4*)(o + i * 256 + lane * 4) = y;
        }
      } else {
        if (from_input && r >= 16384) {
          float* xo = xres_row(p, r);
#pragma unroll
          for (int i = 0; i < 4; ++i) *(float4*)(xo + i * 256 + lane * 4) = v[q][i];
        }
        int cond = rr < 256 ? 2 : b;
        const float* mb = mod + (size_t)(layer * 3 + cond) * 6144 + (which == 0 ? 0 : 3072);
#pragma unroll
        for (int i = 0; i < 4; ++i) {
          int c0 = i * 256 + lane * 4;
          float4 sh = *(const float4*)(mb + c0);
          float4 sc = *(const float4*)(mb + 1024 + c0);
          float y0 = v[q][i].x * rstd * g4[i].x * (1.f + sc.x) + sh.x;
          float y1 = v[q][i].y * rstd * g4[i].y * (1.f + sc.y) + sh.y;
          float y2 = v[q][i].z * rstd * g4[i].z * (1.f + sc.z) + sh.z;
          float y3 = v[q][i].w * rstd * g4[i].w * (1.f + sc.w) + sh.w;
          uint2 u; u.x = pack2(y0, y1); u.y = pack2(y2, y3);
          *(uint2*)(H + (size_t)r * 1024 + c0) = u;
        }
      }
    }
  }
}

DEV void inproj_phase(const Params& p, int layer, char* smem) {
  constexpr int MI = 2;
  u16* P = (u16*)(p.ws + OFF_P);
  const u16* H = (const u16*)(p.ws + OFF_H);
  const u16* WT = (const u16*)(p.ws + OFF_WT_IN);
  const float* cosT = (const float*)(p.ws + OFF_ROPE);
  const float* sinT = cosT + 128 * 16;
  const int x = bid() & 7, lb = bid() >> 3, nl = gridDim.x >> 3;
  int mt, nt;
  for (int j = lb; tile_map(j, x, R / (64 * MI), 33, mt, nt); j += nl) {
    const int t = tid(), lane = t & 63, w = t >> 6, wr = w >> 1, wc = w & 1, r = lane & 31, h = lane >> 5;
    f32x16 acc[MI][2];
    zero_accm<MI, 2>(acc);
    const int m0 = mt * (64 * MI);
    gemm_core<MI, 2>(H, 1024, m0, R - 1, WT, 1024, nt * 128, nt * 128 + 64, 1024, acc, smem);
    const int lrow0 = wr * (32 * MI) + 4 * h;
    if (nt < 5) {
      const float* gain = (nt < 4 ? p.q_norm : p.k_norm) + layer * 64;
      const float g0 = gain[r], g1 = gain[32 + r];
      const float qs = nt < 4 ? 0.125f * 1.4426950408889634f : 1.0f;
      const bool is_ctx = (m0 % RB) < 256;
      u16* tb = P + (size_t)m0 * PW + nt * 128 + wc * 64;
      const int tt0 = (m0 % RB) - 256 + lrow0;
      const int f = r & 15;
#pragma unroll
      for (int mi = 0; mi < MI; ++mi)
#pragma unroll
        for (int rg8 = 0; rg8 < 2; ++rg8) {
          float tc0[8], ts0[8], tc1[8], ts1[8];
#pragma unroll
          for (int e = 0; e < 8; ++e) {
            const int reg = rg8 * 8 + e;
            const int lr = mi * 32 + (reg & 3) + 8 * (reg >> 2);
            int tt = is_ctx ? 0 : tt0 + lr;
            int prow = tt >> 6, pcol = tt & 63;
            tc0[e] = cosT[prow * 16 + f]; ts0[e] = sinT[prow * 16 + f]; tc1[e] = cosT[pcol * 16 + f]; ts1[e] = sinT[pcol * 16 + f];
          }
#pragma unroll
          for (int e = 0; e < 8; ++e) {
            const int reg = rg8 * 8 + e;
            const int lr = mi * 32 + (reg & 3) + 8 * (reg >> 2);
            float v0 = acc[mi][0][reg], v1 = acc[mi][1][reg];
            float ss = v0 * v0 + v1 * v1;
#pragma unroll
            for (int o = 16; o >= 1; o >>= 1) ss += __shfl_xor(ss, o);
            float rstd = rsqrtf(ss * (1.f / 64.f) + 1e-6f);
            v0 = v0 * rstd * g0; v1 = v1 * rstd * g1;
            if (!is_ctx) {
              float p0 = __shfl_xor(v0, 16), p1 = __shfl_xor(v1, 16);
              if (r < 16) { v0 = v0 * tc0[e] - p0 * ts0[e]; v1 = v1 * tc1[e] - p1 * ts1[e]; }
              else { v0 = p0 * ts0[e] + v0 * tc0[e]; v1 = p1 * ts1[e] + v1 * tc1[e]; }
            }
            unsigned off = (unsigned)(lrow0 + lr) * PW + r;
            tb[off] = f2bf(v0 * qs);
            tb[off + 32] = f2bf(v1 * qs);
          }
          __builtin_amdgcn_sched_barrier(0);
        }
    } else if (nt == 5) {
      const int b = m0 / RB, rr0 = m0 - b * RB + lrow0;
      u16* tb = (u16*)(p.ws + OFF_VT) + (size_t)((b * 2 + wc) * 64) * RB;
#pragma unroll
      for (int mi = 0; mi < MI; ++mi)
#pragma unroll
        for (int ni = 0; ni < 2; ++ni)
#pragma unroll
          for (int q = 0; q < 4; ++q) {
            const int T0 = rr0 + mi * 32 + 8 * q;
            const int gi = (T0 >> 2) & 3;
            const int Tp = (T0 & ~15) + 4 * (gi == 1 ? 2 : (gi == 2 ? 1 : gi));
            unsigned off = (unsigned)(ni * 32 + r) * RB + Tp;
            uint2 u; u.x = pack2(acc[mi][ni][4 * q], acc[mi][ni][4 * q + 1]); u.y = pack2(acc[mi][ni][4 * q + 2], acc[mi][ni][4 * q + 3]);
            *(uint2*)(tb + off) = u;
          }
    } else if (nt < 32) {
      u16* tb = P + (size_t)m0 * PW + nt * 128 + wc * 64;
#pragma unroll
      for (int mi = 0; mi < MI; ++mi)
#pragma unroll
        for (int reg = 0; reg < 16; ++reg) {
          unsigned off = (unsigned)(lrow0 + mi * 32 + (reg & 3) + 8 * (reg >> 2)) * PW + r;
          tb[off] = f2bf(acc[mi][0][reg]);
          tb[off + 32] = f2bf(acc[mi][1][reg]);
          if ((reg & 3) == 3) __builtin_amdgcn_sched_barrier(0);
        }
    } else {
      if (wc == 0 && r < 16) {
        float* tb = (float*)(p.ws + OFF_DT) + (size_t)m0 * 16;
        float bias = p.ssd_dt_bias[layer * 16 + r];
#pragma unroll
        for (int mi = 0; mi < MI; ++mi)
#pragma unroll
          for (int reg = 0; reg < 16; ++reg) {
            unsigned off = (unsigned)(lrow0 + mi * 32 + (reg & 3) + 8 * (reg >> 2)) * 16 + r;
            float v = acc[mi][0][reg] + bias;
            float ev = __expf(-fabsf(v));
            float l1 = ev < 0.01f ? ev * (1.f - ev * (0.5f - ev * (1.f / 3.f))) : __logf(1.f + ev);
            tb[off] = fmaxf(v, 0.f) + l1;
            if ((reg & 3) == 3) __builtin_amdgcn_sched_barrier(0);
          }
      }
    }
  }
}

DEV void seq_of_row(int row, int& lo, int& n, int& tt) {
  int b = row / RB, rr = row - b * RB;
  if (rr < 256) { lo = row - rr; n = 256; tt = rr; }
  else { lo = row - rr + 256; n = 8192; tt = rr - 256; }
}
DEV void pooled_item(const Params& p, int it) {
  const u16* P = (const u16*)(p.ws + OFF_P);
  u16* PO = (u16*)(p.ws + OFF_POOLED);
  int t = tid();
  int row = it * 4 + (t >> 6), ch = t & 63;
  int g = ch >> 4, half = 1 << g;
  int lo, n, tt;
  seq_of_row(row, lo, n, tt);
  int a = tt - half < 0 ? 0 : tt - half, bq = tt + half > n ? n : tt + half;
  const u16* base = P + (size_t)lo * PW + C_PU + ch * 8;
  uint4 u[16];
#pragma unroll
  for (int q = 0; q < 16; ++q) {
    int rq = a + q;
    u[q] = rq < bq ? *(const uint4*)(base + (size_t)rq * PW) : make_uint4(0u, 0u, 0u, 0u);
  }
  uint4 us = *(const uint4*)(base + (size_t)tt * PW);
  float s[8];
#pragma unroll
  for (int i = 0; i < 8; ++i) s[i] = 0.f;
#pragma unroll
  for (int q = 0; q < 16; ++q) {
    float f[8]; unpack8(u[q], f);
#pragma unroll
    for (int i = 0; i < 8; ++i) s[i] += f[i];
  }
  float f[8]; unpack8(us, f);
  float inv = 1.f / (float)(bq - a);
#pragma unroll
  for (int i = 0; i < 8; ++i) s[i] = s[i] * inv - f[i];
  *(uint4*)(PO + (size_t)row * 512 + ch * 8) = pack8(s);
}
DEV void sconv_item(const Params& p, int layer, int it) {
  u16* P = (u16*)(p.ws + OFF_P);
  int t = tid();
  int row = it * 4 + (t >> 6), ch = t & 63;
  int lo, n, tt;
  seq_of_row(row, lo, n, tt);
  const float* wc = p.conv_short + layer * 3 * 512 + ch * 8;
  float accv[8];
#pragma unroll
  for (int i = 0; i < 8; ++i) accv[i] = 0.f;
#pragma unroll
  for (int d = -1; d <= 1; ++d) {
    int q = tt + d;
    if (q < 0 || q >= n) continue;
    uint4 ucg = *(const uint4*)(P + (size_t)(lo + q) * PW + C_CG + ch * 8);
    uint4 uu = *(const uint4*)(P + (size_t)(lo + q) * PW + C_U + ch * 8);
    float a[8], b[8]; unpack8(ucg, a); unpack8(uu, b);
    const float* wv = wc + (d + 1) * 512;
#pragma unroll
    for (int i = 0; i < 8; ++i) accv[i] += wv[i] * (a[i] * b[i]);
  }
  uint4 ubg = *(const uint4*)(P + (size_t)row * PW + C_BG + ch * 8);
  float bg[8]; unpack8(ubg, bg);
#pragma unroll
  for (int i = 0; i < 8; ++i) accv[i] *= bg[i];
  *(uint4*)(P + (size_t)row * PW + C_BG + ch * 8) = pack8(accv);
}

struct StageRegs { uint4 u0[4], um[4], up[4]; };
DEV StageRegs ssd_stage_load(const Params& p, int r0, bool has_prev, bool has_next, int col0) {
  const u16* P = (const u16*)(p.ws + OFF_P);
  int t = tid(), s = t & 127, half = t >> 7;
  const bool pm = s > 0 || has_prev, pp = s < 127 || has_next;
  const u16* base = P + (size_t)(r0 + s) * PW + col0 + half * 8;
  StageRegs rg;
#pragma unroll
  for (int j = 0; j < 4; ++j) {
    rg.u0[j] = *(const uint4*)(base + j * 16);
    rg.um[j] = pm ? *(const uint4*)(base + j * 16 - PW) : make_uint4(0u, 0u, 0u, 0u);
    rg.up[j] = pp ? *(const uint4*)(base + j * 16 + PW) : make_uint4(0u, 0u, 0u, 0u);
  }
  return rg;
}
DEV void ssd_stage_put(const Params& p, int layer, const StageRegs& rg, int col0, u16* dst, bool transposed, int stride) {
  int t = tid(), s = t & 127, half = t >> 7;
  const float* cw = p.ssd_conv_w + layer * 3 * 768 + (col0 - C_XS);
  const float* cb = p.ssd_conv_b + layer * 768 + (col0 - C_XS);
#pragma unroll
  for (int j = 0; j < 4; ++j) {
    const int cc = half + 2 * j;
    float x0[8], xm[8], xp[8];
    unpack8(rg.u0[j], x0); unpack8(rg.um[j], xm); unpack8(rg.up[j], xp);
    float v[8];
#pragma unroll
    for (int i = 0; i < 8; ++i) {
      int c = cc * 8 + i;
      float a = cw[c] * xm[i] + cw[768 + c] * x0[i] + cw[1536 + c] * xp[i] + cb[c];
      v[i] = silu_f(a);
    }
    if (!transposed) *(uint4*)(dst + s * stride + cc * 8) = pack8(v);
    else {
#pragma unroll
      for (int i = 0; i < 8; ++i) dst[(cc * 8 + i) * stride + s] = f2bf(v[i]);
    }
  }
}

DEV void ssd_acum(const Params& p, int layer, int r0, int head, int d, int lane, float* acum, float* dts, float& total) {
  const float* DT = (const float*)(p.ws + OFF_DT);
  float arate = -__expf(p.ssd_a_log[layer * 16 + d * 8 + head]);
  int n0 = d == 0 ? 2 * lane : 127 - 2 * lane;
  int n1 = d == 0 ? 2 * lane + 1 : 126 - 2 * lane;
  float dt0 = DT[(size_t)(r0 + n0) * 16 + d * 8 + head], dt1 = DT[(size_t)(r0 + n1) * 16 + d * 8 + head];
  float a0 = dt0 * arate, a1 = dt1 * arate;
  float s = a0 + a1;
#pragma unroll
  for (int o = 1; o < 64; o <<= 1) {
    float tv = __shfl_up(s, o);
    if (lane >= o) s += tv;
  }
  acum[n1] = s; acum[n0] = s - a1;
  dts[n0] = dt0; dts[n1] = dt1;
  total = __shfl(s, 63);
}

constexpr int ST = 136;
DEV void ssd1_item(const Params& p, int layer, int item, char* smem) {
  int b = item / (66 * 8), rem = item - b * 66 * 8, nc = rem >> 3, head = rem & 7, g = head >> 2;
  int r0 = b * RB + nc * 128;
  bool has_prev = !(nc == 0 || nc == 2), has_next = !(nc == 1 || nc == 65);
  u16* sBT = (u16*)smem;
  u16* sXT = sBT + 64 * ST;
  float* sW = (float*)(sXT + 64 * ST);
  float* sA = sW + 256;
  float* sD = sA + 256;
  int t = tid(), lane = t & 63, w = t >> 6, r = lane & 31, h = lane >> 5;
  {
    StageRegs rb = ssd_stage_load(p, r0, has_prev, has_next, C_BM + g * 64);
    StageRegs rx = ssd_stage_load(p, r0, has_prev, has_next, C_XS + head * 64);
    ssd_stage_put(p, layer, rb, C_BM + g * 64, sBT, true, ST);
    ssd_stage_put(p, layer, rx, C_XS + head * 64, sXT, true, ST);
  }
  if (w < 2) {
    float total;
    ssd_acum(p, layer, r0, head, w, lane, sA + w * 128, sD + w * 128, total);
    __builtin_amdgcn_fence(__ATOMIC_RELEASE, "wavefront");
    int n0 = 2 * lane, n1 = 2 * lane + 1;
    sW[w * 128 + n0] = __expf(total - sA[w * 128 + n0]) * sD[w * 128 + n0];
    sW[w * 128 + n1] = __expf(total - sA[w * 128 + n1]) * sD[w * 128 + n1];
    if (lane == 0) ((float*)(p.ws + OFF_DECAY))[((b * 2 + w) * 8 + head) * 66 + nc] = __expf(total);
  }
  __syncthreads();
  int d = w >> 1, pt = w & 1;
  f32x16 acc[2];
#pragma unroll
  for (int i = 0; i < 16; ++i) { acc[0][i] = 0.f; acc[1][i] = 0.f; }
#pragma unroll
  for (int kk = 0; kk < 8; ++kk) {
    int s0 = kk * 16 + h * 8;
    uint4 ua = *(const uint4*)(sXT + (pt * 32 + r) * ST + s0);
    float f[8]; unpack8(ua, f);
    float4 w0 = *(const float4*)(sW + d * 128 + s0), w1 = *(const float4*)(sW + d * 128 + s0 + 4);
    f[0] *= w0.x; f[1] *= w0.y; f[2] *= w0.z; f[3] *= w0.w; f[4] *= w1.x; f[5] *= w1.y; f[6] *= w1.z; f[7] *= w1.w;
    bf16x8 a = as_bf16x8(pack8(f));
    bf16x8 b0 = *(const bf16x8*)(sBT + r * ST + s0);
    bf16x8 b1 = *(const bf16x8*)(sBT + (32 + r) * ST + s0);
    acc[0] = mfma32(a, b0, acc[0]);
    acc[1] = mfma32(a, b1, acc[1]);
  }
  float* S = (float*)(p.ws + OFF_S) + ((size_t)(((b * 2 + d) * 8 + head) * 66 + nc)) * 4096;
#pragma unroll
  for (int ni = 0; ni < 2; ++ni)
#pragma unroll
    for (int reg = 0; reg < 16; ++reg) S[(pt * 32 + rowmap(reg, h)) * 64 + ni * 32 + r] = acc[ni][reg];
  __syncthreads();
}

DEV void ssd2_phase(const Params& p) {
  float* S = (float*)(p.ws + OFF_S);
  const float* DEC = (const float*)(p.ws + OFF_DECAY);
  for (int i = bid() * NTHR + tid(); i < 32 * 4096; i += gridDim.x * NTHR) {
    int seq = i >> 12, e = i & 4095;
    int d = (seq >> 3) & 1;
    float hst = 0.f;
    float* base = S + (size_t)seq * 66 * 4096 + e;
    const float* dec = DEC + seq * 66;
#pragma unroll 1
    for (int s0 = 0; s0 < 66; s0 += 11) {
      float stv[11];
#pragma unroll
      for (int i = 0; i < 11; ++i) {
        int step = s0 + i;
        int nc = d == 0 ? step : (step < 2 ? 1 - step : 67 - step);
        stv[i] = base[(size_t)nc * 4096];
      }
#pragma unroll
      for (int i = 0; i < 11; ++i) {
        int step = s0 + i;
        int nc = d == 0 ? step : (step < 2 ? 1 - step : 67 - step);
        base[(size_t)nc * 4096] = hst;
        hst = hst * dec[nc] + stv[i];
      }
    }
  }
}

DEV void ssd3_item(const Params& p, int layer, int item, char* smem) {
  int b = item / (66 * 8), rem = item - b * 66 * 8, nc = rem >> 3, head = rem & 7, g = head >> 2;
  int r0 = b * RB + nc * 128;
  bool has_prev = !(nc == 0 || nc == 2), has_next = !(nc == 1 || nc == 65);
  u16* sC = (u16*)smem;
  u16* sB = sC + 128 * 72;
  u16* sXT = sB + 128 * 72;
  u16* sHf = sXT + 64 * ST;
  u16* sHb = sHf + 64 * 72;
  float* sA = (float*)(sHb + 64 * 72);
  float* sD = sA + 256;
  int t = tid(), lane = t & 63, w = t >> 6, r = lane & 31, h = lane >> 5;
  {
    StageRegs rc = ssd_stage_load(p, r0, has_prev, has_next, C_CM + g * 64);
    StageRegs rb = ssd_stage_load(p, r0, has_prev, has_next, C_BM + g * 64);
    const float* S = (const float*)(p.ws + OFF_S);
    const int pp = t >> 2, n0 = (t & 3) * 16;
    float4 hv[2][4];
#pragma unroll
    for (int d = 0; d < 2; ++d) {
      const float* src = S + ((size_t)(((b * 2 + d) * 8 + head) * 66 + nc)) * 4096;
#pragma unroll
      for (int i = 0; i < 4; ++i) hv[d][i] = *(const float4*)(src + pp * 64 + n0 + i * 4);
    }
    ssd_stage_put(p, layer, rc, C_CM + g * 64, sC, false, 72);
    StageRegs rx = ssd_stage_load(p, r0, has_prev, has_next, C_XS + head * 64);
    ssd_stage_put(p, layer, rb, C_BM + g * 64, sB, false, 72);
#pragma unroll
    for (int d = 0; d < 2; ++d) {
      u16* dst = d == 0 ? sHf : sHb;
      float f[16];
#pragma unroll
      for (int i = 0; i < 4; ++i) { f[i * 4] = hv[d][i].x; f[i * 4 + 1] = hv[d][i].y; f[i * 4 + 2] = hv[d][i].z; f[i * 4 + 3] = hv[d][i].w; }
      *(uint4*)(dst + pp * 72 + n0) = pack8(f);
      *(uint4*)(dst + pp * 72 + n0 + 8) = pack8(f + 8);
    }
    ssd_stage_put(p, layer, rx, C_XS + head * 64, sXT, true, ST);
  }
  if (w < 2) {
    float total;
    ssd_acum(p, layer, r0, head, w, lane, sA + w * 128, sD + w * 128, total);
  }
  __syncthreads();
  const int l0 = w * 32;
  bf16x8 cf[4];
#pragma unroll
  for (int kk = 0; kk < 4; ++kk) cf[kk] = *(const bf16x8*)(sC + (l0 + r) * 72 + kk * 16 + h * 8);
  f32x16 X[4];
#pragma unroll
  for (int st = 0; st < 4; ++st) {
#pragma unroll
    for (int i = 0; i < 16; ++i) X[st][i] = 0.f;
#pragma unroll
    for (int kk = 0; kk < 4; ++kk) {
      bf16x8 a = *(const bf16x8*)(sB + (st * 32 + r) * 72 + kk * 16 + h * 8);
      X[st] = mfma32(a, cf[kk], X[st]);
    }
  }
  const int l = l0 + r;
  const float Af_l = sA[l], Ab_l = sA[128 + l];
  f32x16 Y[2];
#pragma unroll
  for (int pt = 0; pt < 2; ++pt)
#pragma unroll
    for (int i = 0; i < 16; ++i) Y[pt][i] = 0.f;
#pragma unroll 1
  for (int d = 0; d < 2; ++d) {
    const u16* sH = d == 0 ? sHf : sHb;
    const float e = __expf(d == 0 ? Af_l : Ab_l);
#pragma unroll
    for (int pt = 0; pt < 2; ++pt) {
      f32x16 T;
#pragma unroll
      for (int i = 0; i < 16; ++i) T[i] = 0.f;
#pragma unroll
      for (int kk = 0; kk < 4; ++kk) {
        bf16x8 af = *(const bf16x8*)(sH + (pt * 32 + r) * 72 + kk * 16 + h * 8);
        T = mfma32(af, cf[kk], T);
      }
#pragma unroll
      for (int i = 0; i < 16; ++i) Y[pt][i] += T[i] * e;
    }
  }
#pragma unroll
  for (int d = 0; d < 2; ++d) {
    const float A_l = d == 0 ? Af_l : Ab_l;
    const float* sAd = sA + d * 128;
    const float* sDd = sD + d * 128;
#pragma unroll
    for (int st = 0; st < 4; ++st) {
      if (d == 0 ? (st > w) : (st < w)) continue;
      float wv[16];
#pragma unroll
      for (int reg = 0; reg < 16; ++reg) {
        int s = st * 32 + rowmap(reg, h);
        bool ok = d == 0 ? (s <= l) : (s >= l);
        float e = ok ? __expf(A_l - sAd[s]) * sDd[s] : 0.f;
        wv[reg] = X[st][reg] * e;
      }
#pragma unroll
      for (int sp = 0; sp < 2; ++sp) {
        bf16x8 bfrag = as_bf16x8(pack8(wv + sp * 8));
#pragma unroll
        for (int pt = 0; pt < 2; ++pt) {
          const u16* base = sXT + (pt * 32 + r) * ST + st * 32 + sp * 16 + 4 * h;
          uint2 lo = *(const uint2*)base, hi = *(const uint2*)(base + 8);
          uint4 ua; ua.x = lo.x; ua.y = lo.y; ua.z = hi.x; ua.w = hi.y;
          Y[pt] = mfma32(as_bf16x8(ua), bfrag, Y[pt]);
        }
      }
    }
  }
  u16* P = (u16*)(p.ws + OFF_P);
  const float dsk = p.ssd_d[layer * 8 + head];
  const int row = r0 + l;
  float ssq = 0.f;
  uint2 zpre[2][4];
#pragma unroll
  for (int pt = 0; pt < 2; ++pt)
#pragma unroll
    for (int q = 0; q < 4; ++q) zpre[pt][q] = *(const uint2*)(P + (size_t)row * PW + C_Z + head * 64 + pt * 32 + 8 * q + 4 * h);
#pragma unroll
  for (int pt = 0; pt < 2; ++pt)
#pragma unroll
    for (int q = 0; q < 4; ++q) {
      int p0 = pt * 32 + 8 * q + 4 * h;
      u16* zp = P + (size_t)row * PW + C_Z + head * 64 + p0;
      uint2 uz = zpre[pt][q];
      float z[4] = {bflo(uz.x), bfhi(uz.x), bflo(uz.y), bfhi(uz.y)};
      float gv[4];
#pragma unroll
      for (int i = 0; i < 4; ++i) {
        float xs = bf2f(sXT[(p0 + i) * ST + l]);
        float y = Y[pt][4 * q + i] + dsk * xs;
        gv[i] = y * silu_f(z[i]);
        ssq += gv[i] * gv[i];
      }
      uint2 uo; uo.x = pack2(gv[0], gv[1]); uo.y = pack2(gv[2], gv[3]);
      *(uint2*)zp = uo;
    }
  ssq += __shfl_xor(ssq, 32);
  if (h == 0) ((float*)(p.ws + OFF_SSQ))[(size_t)row * 8 + head] = ssq;
  __syncthreads();
}

DEV void attn_item(const Params& p, int b, int head, int qrow0, int nkeys, u16* outp, int ostride, char* smem) {
  u16* P = (u16*)(p.ws + OFF_P);
  const u16* VT = (const u16*)(p.ws + OFF_VT);
  const int t = tid(), lane = t & 63, w = t >> 6, r = lane & 31, h = lane >> 5;
  const int g = head >> 2;
  const u16* Kb = P + (size_t)(b * RB) * PW + C_K + g * 64;
  const u16* Vb = VT + (size_t)((b * 2 + g) * 64) * RB;
  bf16x8 qf[2][4];
#pragma unroll
  for (int qs = 0; qs < 2; ++qs)
#pragma unroll
    for (int kk = 0; kk < 4; ++kk)
      qf[qs][kk] = *(const bf16x8*)(P + (size_t)(qrow0 + w * 64 + qs * 32 + r) * PW + C_Q + head * 64 + kk * 16 + h * 8);
  f32x16 o[2][2];
  zero_acc<2>(o);
  float m[2] = {0.f, 0.f}, lsum[2] = {0.f, 0.f};
  u16* sbuf = (u16*)smem;
  const int c8 = (t & 7) * 8, ro = t >> 3;
  const u16* kp0 = Kb + (size_t)ro * PW + c8;
  const u16* vp0 = Vb + (size_t)ro * RB + c8;
  uint4 rk0 = *(const uint4*)(kp0), rk1 = *(const uint4*)(kp0 + (size_t)32 * PW);
  uint4 rv0 = *(const uint4*)(vp0), rv1 = *(const uint4*)(vp0 + (size_t)32 * RB);
  const int sofs = ro * 72 + c8;
  *(uint4*)(sbuf + sofs) = rk0;
  *(uint4*)(sbuf + sofs + 32 * 72) = rk1;
  *(uint4*)(sbuf + 64 * 72 + sofs) = rv0;
  *(uint4*)(sbuf + 64 * 72 + sofs + 32 * 72) = rv1;
  __syncthreads();
  const int ntile = nkeys >> 6;
  for (int kt = 0; kt < ntile; ++kt) {
    const bool more = kt + 1 < ntile;
    if (more) {
      int k0 = (kt + 1) << 6;
      rk0 = *(const uint4*)(kp0 + (size_t)k0 * PW);
      rk1 = *(const uint4*)(kp0 + (size_t)(k0 + 32) * PW);
      rv0 = *(const uint4*)(vp0 + k0);
      rv1 = *(const uint4*)(vp0 + (size_t)32 * RB + k0);
    }
    const u16* sK = sbuf + (kt & 1) * (128 * 72);
    const u16* sV = sK + 64 * 72;
    f32x16 s[2][2];
    const bool anym = __builtin_amdgcn_ballot_w64(m[0] != 0.f || m[1] != 0.f) != 0ull;
    if (anym) {
#pragma unroll
      for (int ks = 0; ks < 2; ++ks)
#pragma unroll
        for (int qs = 0; qs < 2; ++qs)
#pragma unroll
          for (int i = 0; i < 16; ++i) s[ks][qs][i] = -m[qs];
#pragma unroll
      for (int ks = 0; ks < 2; ++ks)
#pragma unroll
        for (int kk = 0; kk < 4; ++kk) {
          bf16x8 a = *(const bf16x8*)(sK + (ks * 32 + r) * 72 + kk * 16 + h * 8);
          const bf16x8 q0 = qf[0][kk], q1 = qf[1][kk];
          s[ks][0] = mfma32(a, q0, s[ks][0]);
          s[ks][1] = mfma32(a, q1, s[ks][1]);
        }
    } else {
      const f32x16 zero16 = {0.f, 0.f, 0.f, 0.f, 0.f, 0.f, 0.f, 0.f, 0.f, 0.f, 0.f, 0.f, 0.f, 0.f, 0.f, 0.f};
#pragma unroll
      for (int ks = 0; ks < 2; ++ks)
#pragma unroll
        for (int kk = 0; kk < 4; ++kk) {
          bf16x8 a = *(const bf16x8*)(sK + (ks * 32 + r) * 72 + kk * 16 + h * 8);
          const bf16x8 q0 = qf[0][kk], q1 = qf[1][kk];
          s[ks][0] = mfma32(a, q0, kk == 0 ? zero16 : s[ks][0]);
          s[ks][1] = mfma32(a, q1, kk == 0 ? zero16 : s[ks][1]);
        }
    }
    uint4 pf[2][2][2];
#pragma unroll
    for (int qs = 0; qs < 2; ++qs) {
      float rs = 0.f;
#pragma unroll
      for (int ks = 0; ks < 2; ++ks) {
        float pv[16];
#pragma unroll
        for (int i = 0; i < 16; ++i) { pv[i] = __builtin_amdgcn_exp2f(s[ks][qs][i]); rs += pv[i]; }
        pf[ks][0][qs] = pack8(pv);
        pf[ks][1][qs] = pack8(pv + 8);
      }
      if (__builtin_amdgcn_ballot_w64(!(rs < 1.0e9f)) != 0ull) {
        float mx = s[0][qs][0];
#pragma unroll
        for (int i = 1; i < 16; ++i) mx = fmaxf(mx, s[0][qs][i]);
#pragma unroll
        for (int i = 0; i < 16; ++i) mx = fmaxf(mx, s[1][qs][i]);
        mx = fmaxf(mx, __shfl_xor(mx, 32));
        const float d = fmaxf(mx - 8.f, 0.f);
        const float alpha = __builtin_amdgcn_exp2f(-d);
        m[qs] += d;
        lsum[qs] *= alpha;
#pragma unroll
        for (int i = 0; i < 16; ++i) { o[0][qs][i] *= alpha; o[1][qs][i] *= alpha; }
        rs = 0.f;
#pragma unroll
        for (int ks = 0; ks < 2; ++ks) {
          float pv[16];
#pragma unroll
          for (int i = 0; i < 16; ++i) { pv[i] = __builtin_amdgcn_exp2f(s[ks][qs][i] - d); rs += pv[i]; }
          pf[ks][0][qs] = pack8(pv);
          pf[ks][1][qs] = pack8(pv + 8);
        }
      }
      lsum[qs] += rs;
    }
#pragma unroll
    for (int ds = 0; ds < 2; ++ds)
#pragma unroll
      for (int ks = 0; ks < 2; ++ks)
#pragma unroll
        for (int sp = 0; sp < 2; ++sp) {
          bf16x8 a = *(const bf16x8*)(sV + (ds * 32 + r) * 72 + ks * 32 + sp * 16 + 8 * h);
          o[ds][0] = mfma32(a, as_bf16x8(pf[ks][sp][0]), o[ds][0]);
          o[ds][1] = mfma32(a, as_bf16x8(pf[ks][sp][1]), o[ds][1]);
        }
    if (more) {
      u16* nxt = sbuf + ((kt + 1) & 1) * (128 * 72);
      *(uint4*)(nxt + sofs) = rk0;
      *(uint4*)(nxt + sofs + 32 * 72) = rk1;
      *(uint4*)(nxt + 64 * 72 + sofs) = rv0;
      *(uint4*)(nxt + 64 * 72 + sofs + 32 * 72) = rv1;
    }
    __syncthreads();
  }
#pragma unroll
  for (int qs = 0; qs < 2; ++qs) {
    float lt = lsum[qs] + __shfl_xor(lsum[qs], 32);
    float inv = 1.f / lt;
    int row = qrow0 + w * 64 + qs * 32 + r;
#pragma unroll
    for (int ds = 0; ds < 2; ++ds)
#pragma unroll
      for (int q = 0; q < 4; ++q) {
        int d0 = ds * 32 + 8 * q + 4 * h;
        uint2 u; u.x = pack2(o[ds][qs][4 * q] * inv, o[ds][qs][4 * q + 1] * inv);
        u.y = pack2(o[ds][qs][4 * q + 2] * inv, o[ds][qs][4 * q + 3] * inv);
        *(uint2*)(outp + (size_t)row * ostride + head * 64 + d0) = u;
      }
  }
}

template <int NI>
DEV void merge_phase(const Params& p, int mode, char* smem) {
  const bool lat_only = mode == 1;
  u16* P = (u16*)(p.ws + OFF_P);
  const u16* H = (const u16*)(p.ws + OFF_H);
  const u16* WTI = (const u16*)(p.ws + OFF_WT_IN);
  const u16* WTB = (const u16*)(p.ws + OFF_WT_BR);
  const u16* PO = (const u16*)(p.ws + OFF_POOLED);
  const float* SSQ = (const float*)(p.ws + OFF_SSQ);
  const int x = bid() & 7, lb = bid() >> 3, nl = gridDim.x >> 3;
  int mt, nt;
  for (int j = lb;; j += nl) {
    if (mode == 3) {
      int tile = bid() + (j - lb) / nl * (int)gridDim.x;
      if (tile >= 4 * (16 / NI)) break;
      mt = 128 + tile / (16 / NI); nt = tile % (16 / NI);
    } else if (!tile_map(j, x, 128, 16 / NI, mt, nt)) break;
    const int t = tid(), lane = t & 63, w = t >> 6, wr = w >> 1, wc = w & 1, r = lane & 31, h = lane >> 5;
    const int m0 = lat_only ? (mt >> 6) * RB + 256 + (mt & 63) * 128 : mt * 128, n0 = nt * (64 * NI);
    f32x16 tot[2][NI];
    zero_accm<2, NI>(tot);
#pragma unroll 1
    for (int k = 0; k < 4; ++k) {
      unsigned gp[2][NI][8];
      {
        f32x16 gacc[2][NI];
        zero_accm<2, NI>(gacc);
        int br = 4112 + k * 1024 + n0;
        gemm_core<2, NI>(H, 1024, m0, R - 1, WTI, 1024, br, br + 64, 1024, gacc, smem);
#pragma unroll
        for (int a = 0; a < 2; ++a)
#pragma unroll
          for (int bq = 0; bq < NI; ++bq)
#pragma unroll
            for (int i = 0; i < 8; ++i) gp[a][bq][i] = pack2(sigmoid_f(gacc[a][bq][2 * i]), sigmoid_f(gacc[a][bq][2 * i + 1]));
      }
      f32x16 pacc[2][NI];
      zero_accm<2, NI>(pacc);
      const u16* A; int lda;
      if (k == 0) { A = P + C_Q; lda = PW; }
      else if (k == 1) { A = P + C_BG; lda = PW; }
      else if (k == 2) { A = PO; lda = 512; }
      else { A = P + C_Z; lda = PW; }
      gemm_core<2, NI>(A, lda, m0, R - 1, WTB + (size_t)k * 1024 * 512, 512, n0, n0 + 64, 512, pacc, smem);
      if (k == 3) {
        const float* sb = SSQ + (size_t)m0 * 8;
#pragma unroll
        for (int mi = 0; mi < 2; ++mi)
#pragma unroll
          for (int reg = 0; reg < 16; ++reg) {
            unsigned off = (unsigned)(wr * 64 + 4 * h + mi * 32 + (reg & 3) + 8 * (reg >> 2)) * 8;
            const float4* sp = (const float4*)(sb + off);
            float4 s0 = sp[0], s1 = sp[1];
            float ss = s0.x + s0.y + s0.z + s0.w + s1.x + s1.y + s1.z + s1.w;
            float rstd = rsqrtf(ss * (1.f / 512.f) + 1e-6f);
#pragma unroll
            for (int bq = 0; bq < NI; ++bq) pacc[mi][bq][reg] *= rstd;
          }
      }
#pragma unroll
      for (int a = 0; a < 2; ++a)
#pragma unroll
        for (int bq = 0; bq < NI; ++bq)
#pragma unroll
          for (int i = 0; i < 8; ++i) {
            tot[a][bq][2 * i] += bflo(gp[a][bq][i]) * pacc[a][bq][2 * i];
            tot[a][bq][2 * i + 1] += bfhi(gp[a][bq][i]) * pacc[a][bq][2 * i + 1];
          }
    }
    u16* tb = P + (size_t)m0 * PW + C_YM + n0 + wc * (32 * NI);
#pragma unroll
    for (int mi = 0; mi < 2; ++mi)
#pragma unroll
      for (int reg = 0; reg < 16; ++reg) {
        unsigned off = (unsigned)(wr * 64 + 4 * h + mi * 32 + (reg & 3) + 8 * (reg >> 2)) * PW + r;
#pragma unroll
        for (int bq = 0; bq < NI; ++bq) tb[off + bq * 32] = f2bf(tot[mi][bq][reg]);
      }
  }
}

template <int MI>
DEV void resid_gemm_phase(const Params& p, int layer, int which, bool from_input, char* smem) {
  const u16* P = (const u16*)(p.ws + OFF_P);
  const float* mod = (const float*)(p.ws + OFF_MOD);
  const int x = bid() & 7, lb = bid() >> 3, nl = gridDim.x >> 3;
  int mt, nt;
  for (int j = lb; tile_map(j, x, MI == 4 ? 64 : 128, 8, mt, nt); j += nl) {
    const int t = tid(), lane = t & 63, w = t >> 6, wr = w >> 1, wc = w & 1, r = lane & 31, h = lane >> 5;
    const int m0 = MI == 4 ? (mt >> 5) * RB + 256 + (mt & 31) * 256 : mt * 128, n0 = nt * 128;
    f32x16 acc[MI][2];
    zero_accm<MI, 2>(acc);
    if (which == 0) gemm_core<MI, 2>(P + C_YM, PW, m0, R - 1, (const u16*)(p.ws + OFF_WT_OUT), 1024, n0, n0 + 64, 1024, acc, smem);
    else gemm_core<MI, 2>(P, 2816, m0, R - 1, (const u16*)(p.ws + OFF_WT_DOWN), 2816, n0, n0 + 64, 2816, acc, smem);
    const int cond = cond_of_row(m0);
    const float* gate = mod + (size_t)(layer * 3 + cond) * 6144 + (which == 0 ? 2048 : 5120) + n0 + wc * 64;
    const float* sb = (from_input ? xin_row(p, m0) : xres_row(p, m0)) + n0 + wc * 64;
    float* db = xres_row(p, m0) + n0 + wc * 64;
    const float gv0 = gate[r], gv1 = gate[32 + r];
#pragma unroll
    for (int mi = 0; mi < MI; ++mi) {
      float x0[16], x1[16];
      const float* sbm = sb + (size_t)(wr * (32 * MI) + 4 * h + mi * 32) * 1024 + r;
      float* dbm = db + (size_t)(wr * (32 * MI) + 4 * h + mi * 32) * 1024 + r;
#pragma unroll
      for (int reg = 0; reg < 16; ++reg) {
        unsigned off = (unsigned)((reg & 3) + 8 * (reg >> 2)) * 1024;
        x0[reg] = sbm[off]; x1[reg] = sbm[off + 32];
      }
      __builtin_amdgcn_sched_barrier(0);
#pragma unroll
      for (int reg = 0; reg < 16; ++reg) {
        unsigned off = (unsigned)((reg & 3) + 8 * (reg >> 2)) * 1024;
        dbm[off] = x0[reg] + gv0 * acc[mi][0][reg];
        dbm[off + 32] = x1[reg] + gv1 * acc[mi][1][reg];
      }
      __builtin_amdgcn_sched_barrier(0);
    }
  }
  if (MI == 2) {
    const int S = which == 0 ? 16 : 11, Ksub = which == 0 ? 64 : 256;
    for (int li = bid(); li < 32 * S; li += gridDim.x) {
      const int t = tid(), lane = t & 63, w = t >> 6, wr = w >> 1, wc = w & 1, r = lane & 31, h = lane >> 5;
      const int tile = li / S, ks = li - tile * S;
      const int m0 = (128 + (tile >> 3)) * 128, n0 = (tile & 7) * 128, koff = ks * Ksub;
      f32x16 acc[2][2];
      zero_accm<2, 2>(acc);
      if (which == 0) gemm_core<2, 2>(P + C_YM + koff, PW, m0, R - 1, (const u16*)(p.ws + OFF_WT_OUT) + koff, 1024, n0, n0 + 64, Ksub, acc, smem);
      else gemm_core<2, 2>(P + koff, 2816, m0, R - 1, (const u16*)(p.ws + OFF_WT_DOWN) + koff, 2816, n0, n0 + 64, Ksub, acc, smem);
      const float* gate = mod + (size_t)(layer * 3 + 1) * 6144 + (which == 0 ? 2048 : 5120) + n0 + wc * 64;
      float* db = xres_row(p, m0) + n0 + wc * 64;
      const float gv0 = gate[r], gv1 = gate[32 + r];
#pragma unroll
      for (int mi = 0; mi < 2; ++mi)
#pragma unroll
        for (int reg = 0; reg < 16; ++reg) {
          unsigned off = (unsigned)(wr * 64 + 4 * h + mi * 32 + (reg & 3) + 8 * (reg >> 2)) * 1024 + r;
          atomicAdd(db + off, gv0 * acc[mi][0][reg]);
          atomicAdd(db + off + 32, gv1 * acc[mi][1][reg]);
          if ((reg & 3) == 3) __builtin_amdgcn_sched_barrier(0);
        }
    }
  }
}

DEV void ffn_up_phase(const Params& p, int layer, char* smem) {
  constexpr int MI = 4, TR = 64 * MI, SS = 136;
  u16* ACT = (u16*)(p.ws + OFF_P);
  const u16* H = (const u16*)(p.ws + OFF_H);
  const u16* WT = (const u16*)(p.ws + OFF_WT_UP);
  const float* fc = p.ffn_conv + (size_t)layer * 3 * 5632;
  u16* stg = (u16*)smem;
  const int x = bid() & 7, lb = bid() >> 3, nl = gridDim.x >> 3;
  int mt, nt;
  for (int j = lb; tile_map(j, x, 67, 44, mt, nt); j += nl) {
    const int t = tid(), lane = t & 63, w = t >> 6, wr = w >> 1, wc = w & 1, r = lane & 31, h = lane >> 5;
    const int mrow0 = mt * (TR - 2) - 1;
    f32x16 acc[MI][2];
    zero_accm<MI, 2>(acc);
    gemm_core<MI, 2>(H, 1024, mrow0, R - 1, WT, 1024, nt * 64, 2816 + nt * 64, 1024, acc, smem);
#pragma unroll
    for (int mi = 0; mi < MI; ++mi)
#pragma unroll
      for (int ni = 0; ni < 2; ++ni)
#pragma unroll
        for (int reg = 0; reg < 16; ++reg)
          stg[(wr * (32 * MI) + mi * 32 + rowmap(reg, h)) * SS + wc * 64 + ni * 32 + r] = f2bf(acc[mi][ni][reg]);
    __syncthreads();
    {
      const int jc = (t & 31) * 2, rg = t >> 5;
      const int col = nt * 64 + jc;
      const float2 wg0 = *(const float2*)(fc + col), wg1 = *(const float2*)(fc + 5632 + col), wg2 = *(const float2*)(fc + 2 * 5632 + col);
      const float2 wv0 = *(const float2*)(fc + 2816 + col), wv1 = *(const float2*)(fc + 5632 + 2816 + col), wv2 = *(const float2*)(fc + 2 * 5632 + 2816 + col);
      int nit = (TR - 2 - (1 + rg)) / 8 + 1;
      { int lim = R - mrow0 - (1 + rg); int nv = lim <= 0 ? 0 : (lim + 7) / 8; nit = nit < nv ? nit : nv; }
#pragma unroll 4
      for (int q = 0; q < nit; ++q) {
        const int i = 1 + rg + 8 * q;
        int gr = mrow0 + i;
        int rr = gr % RB;
        bool first = (rr == 0) || (rr == 256), last = (rr == 255) || (rr == RB - 1);
        unsigned gm = first ? 0u : *(const unsigned*)(stg + (i - 1) * SS + jc), g0 = *(const unsigned*)(stg + i * SS + jc);
        unsigned gp = last ? 0u : *(const unsigned*)(stg + (i + 1) * SS + jc);
        unsigned vm = first ? 0u : *(const unsigned*)(stg + (i - 1) * SS + 64 + jc), v0 = *(const unsigned*)(stg + i * SS + 64 + jc);
        unsigned vp = last ? 0u : *(const unsigned*)(stg + (i + 1) * SS + 64 + jc);
        float cg0 = wg0.x * bflo(gm) + wg1.x * bflo(g0) + wg2.x * bflo(gp);
        float cg1 = wg0.y * bfhi(gm) + wg1.y * bfhi(g0) + wg2.y * bfhi(gp);
        float cv0 = wv0.x * bflo(vm) + wv1.x * bflo(v0) + wv2.x * bflo(vp);
        float cv1 = wv0.y * bfhi(vm) + wv1.y * bfhi(v0) + wv2.y * bfhi(vp);
        *(unsigned*)(ACT + (size_t)gr * 2816 + col) = pack2(silu_f(cg0) * cv0, silu_f(cg1) * cv1);
      }
    }
    __syncthreads();
  }
}

#define XB_TMO      128
#define XB_XCNT(j)  (256  + 64 * (j))
#define XB_XSUB(j)  (1280 + 64 * (j))
#define XB_XGEN(j)  (2304 + 64 * (j))
#define XB_TOP      3328
#define XB_TOPGEN   3392
#define XCD_BAR_WORDS 3456
#define XB_SPIN_CAP (1u << 18)
#define LAS __attribute__((address_space(3)))
DEV unsigned xb_ld(unsigned* p) { return __hip_atomic_load(p, __ATOMIC_RELAXED, __HIP_MEMORY_SCOPE_AGENT); }
DEV unsigned xb_add(unsigned* p, unsigned v) { return __hip_atomic_fetch_add(p, v, __ATOMIC_RELAXED, __HIP_MEMORY_SCOPE_AGENT); }
DEV unsigned xb_xcc_id() { return (unsigned)__builtin_amdgcn_s_getreg((3 << 11) | 20) & 0xFu; }
#define XB_SPIN(cond, bar) do { unsigned _sp = 0; while (cond) { __builtin_amdgcn_s_sleep(1); \
    if ((++_sp & 255u) == 0u) { if (xb_ld(&(bar)[XB_TMO])) break; if (_sp > XB_SPIN_CAP) { atomicAdd(&(bar)[XB_TMO], 1u); break; } } } } while (0)
struct XcdBarrier { unsigned* bar; unsigned x; volatile LAS unsigned* st; };
DEV XcdBarrier xcd_barrier_post(unsigned* bar, volatile LAS unsigned* st) {
  XcdBarrier b; b.bar = bar; b.x = xb_xcc_id(); b.st = st;
  if (__builtin_amdgcn_workitem_id_x() == 0) (void)xb_add(&bar[XB_XCNT(b.x)], 1u);
  return b;
}
DEV void xcd_barrier_complete(unsigned* bar, unsigned x, unsigned& nloc, unsigned& nx) {
  const unsigned G = gridDim.x * gridDim.y * gridDim.z;
  unsigned sum, cnt, mine, sp = 0u;
  for (;;) {
    sum = 0u; cnt = 0u; mine = 0u;
#pragma unroll
    for (unsigned j = 0; j < 16; ++j) { const unsigned c = xb_ld(&bar[XB_XCNT(j)]); sum += c; cnt += (c > 0u) ? 1u : 0u; mine = (j == x) ? c : mine; }
    if (sum == G) break;
    __builtin_amdgcn_s_sleep(1);
    if ((++sp & 255u) == 0u) { if (xb_ld(&bar[XB_TMO])) break; if (sp > XB_SPIN_CAP) { atomicAdd(&bar[XB_TMO], 1u); break; } }
  }
  nloc = mine > 0u ? mine : 1u; nx = cnt > 0u ? cnt : 1u;
}
DEV void xcd_barrier(const XcdBarrier& b) {
  asm volatile("s_waitcnt vmcnt(0)" ::: "memory");
  __syncthreads();
  if (__builtin_amdgcn_workitem_id_x() == 0) {
    unsigned* bar = b.bar;
    __builtin_amdgcn_s_waitcnt(0);
    unsigned nloc = b.st[0], nx = b.st[1];
    if (nloc == 0u) { xcd_barrier_complete(bar, b.x, nloc, nx); b.st[0] = nloc; b.st[1] = nx; }
    const unsigned old = xb_add(&bar[XB_XSUB(b.x)], 1u);
    const unsigned gen = old / nloc;
    if (old + 1u == (gen + 1u) * nloc) {
      __builtin_amdgcn_fence(__ATOMIC_RELEASE, "agent");
      asm volatile("s_waitcnt vmcnt(0)" ::: "memory");
      const unsigned og = xb_add(&bar[XB_TOP], 1u);
      const unsigned tg = og / nx;
      if (og + 1u == (tg + 1u) * nx) xb_add(&bar[XB_TOPGEN], 1u);
      else XB_SPIN(xb_ld(&bar[XB_TOPGEN]) == tg, bar);
      __builtin_amdgcn_fence(__ATOMIC_ACQUIRE, "agent");
      xb_add(&bar[XB_XGEN(b.x)], 1u);
      asm volatile("s_waitcnt vmcnt(0)" ::: "memory");
    } else {
      XB_SPIN(xb_ld(&bar[XB_XGEN(b.x)]) == gen, bar);
      __builtin_amdgcn_fence(__ATOMIC_ACQUIRE, "agent");
      asm volatile("s_waitcnt vmcnt(0)" ::: "memory");
    }
  }
  __syncthreads();
}

#ifndef PROBE
#define PROBE 0
#endif
DEV void run_phase(const Params& p, int ph, char* smem, bool dup) {
  if (ph == 0) {
    for (int it = bid(); it < 384; it += gridDim.x) mod_item(p, it, smem);
    {
      float* cosT = (float*)(p.ws + OFF_ROPE);
      float* sinT = cosT + 128 * 16;
      for (int i = bid() * NTHR + tid(); i < 2048; i += gridDim.x * NTHR) {
        int pos = i >> 4, f = i & 15;
        float inv = powf(10000.f, -(float)f / 16.f);
        float ang = (float)pos * inv;
        cosT[i] = cosf(ang); sinT[i] = sinf(ang);
      }
    }
    convert_weights(p, 0, 0, smem);
    return;
  }
  if (ph == 21) { norm_phase(p, 0, 2, false); return; }
  const int layer = (ph - 1) / 10, q = (ph - 1) % 10;
  switch (q) {
    case 0:
      norm_phase(p, layer, 0, layer == 0);
      break;
    case 1: inproj_phase(p, layer, smem); break;
    case 2: {
      const int n1 = 2 * 66 * 8, n2 = R / 4;
      for (int it = bid(); it < n1 + 2 * n2; it += gridDim.x) {
        if (it < n1) ssd1_item(p, layer, it, smem);
        else if (it < n1 + n2) pooled_item(p, it - n1);
        else if (!dup) sconv_item(p, layer, it - n1 - n2);
      }
    } break;
    case 3: ssd2_phase(p); if (!dup) convert_weights(p, layer, 1, smem); break;
    case 4: {
      const int na = layer == 0 ? 512 + 16 : 512, ns = 2 * 66 * 8;
#pragma unroll 1
      for (int it = bid(); it < na; it += gridDim.x) {
        int b, head, qrow0, nkeys;
        if (it < 512) {
          int xx = it & 7, jj = it >> 3;
          b = xx >> 2;
          int g = (xx >> 1) & 1, sub = (xx & 1) * 64 + jj;
          head = g * 4 + (sub >> 5);
          qrow0 = b * RB + 256 + (sub & 31) * 256; nkeys = RB;
        } else {
          int jj = it - 512;
          b = jj >> 3; head = jj & 7; qrow0 = b * RB; nkeys = 256;
        }
        if (dup) attn_item(p, b, head, qrow0, nkeys, (u16*)p.out, 512, smem);
        else attn_item(p, b, head, qrow0, nkeys, (u16*)(p.ws + OFF_P) + C_Q, PW, smem);
      }
      if (dup) break;
#pragma unroll 1
      for (int it = (bid() + gridDim.x - (na % gridDim.x)) % gridDim.x; it < ns; it += gridDim.x) {
        if (layer == 1 && ((it % (66 * 8)) >> 3) < 2) continue;
        ssd3_item(p, layer, it, smem);
      }
    } break;
    case 5: if (layer == 0) { merge_phase<2>(p, 2, smem); merge_phase<1>(p, 3, smem); } else merge_phase<2>(p, 1, smem); break;
    case 6: if (layer == 0) resid_gemm_phase<2>(p, layer, 0, true, smem); else resid_gemm_phase<4>(p, layer, 0, false, smem); break;
    case 7: norm_phase(p, layer, 1, false); if (layer == 0 && !dup) convert_weights(p, 1, 0, smem); break;
    case 8: ffn_up_phase(p, layer, smem); break;
    case 9: if (layer == 0) resid_gemm_phase<2>(p, layer, 1, false, smem); else resid_gemm_phase<4>(p, layer, 1, false, smem); break;
  }
}

__global__ void __launch_bounds__(NTHR, 2) mega(Params p) {
  __shared__ __attribute__((aligned(16))) char smem[SMEM_BYTES];
  cg::grid_group grid = cg::this_grid();
  if (p.phase_lo < 0) grid.sync();
  uint4* xbw = (uint4*)(smem + SMEM_BYTES - 16);
  if (__builtin_amdgcn_workitem_id_x() == 0) *xbw = make_uint4(0u, 0u, 0u, 0u);
  __syncthreads();
  XcdBarrier xb = xcd_barrier_post((unsigned*)(p.ws + OFF_BAR), (volatile LAS unsigned*)xbw);
  for (int ph = p.phase_lo; ph < p.phase_hi; ++ph) {
    run_phase(p, ph, smem, false);
#if PROBE
    {
      const int q = ph >= 1 && ph <= 20 ? (ph - 1) % 10 : -1, layer = (ph - 1) / 10;
      bool m = false;
      if (PROBE == 1) m = q == 1;
      if (PROBE == 2) m = q == 4 && layer == 0;
      if (PROBE == 3) m = q == 5;
      if (PROBE == 4) m = q == 8;
      if (PROBE == 5) m = q == 7;
      if (PROBE == 6) m = q == 2;
      if (PROBE == 9) m = ph == 0;
      if (PROBE == 10) m = q == 6 && layer == 0;
      if (PROBE == 7) { if (q >= 0) { xcd_barrier(xb); xcd_barrier(xb); } }
      if (m) { xcd_barrier(xb); run_phase(p, ph, smem, true); }
    }
#endif
    if (ph + 1 < p.phase_hi) xcd_barrier(xb);
  }
}

extern "C" void kernel_launch(void* const* d_in, const int* in_sizes, int n_in, void* d_out, int out_size, void* d_ws,
                              size_t ws_size, hipStream_t stream) {
  static int grid_blocks = 0;
  if (!grid_blocks) {
    int dev = 0, cus = 0, per_cu = 0;
    hipGetDevice(&dev);
    hipDeviceGetAttribute(&cus, hipDeviceAttributeMultiprocessorCount, dev);
    hipOccupancyMaxActiveBlocksPerMultiprocessor(&per_cu, mega, NTHR, 0);
    if (per_cu > 2) per_cu = 2;
    if (per_cu < 1) per_cu = 1;
    grid_blocks = cus * per_cu;
    grid_blocks -= grid_blocks % 8;
    if (ws_size < WS_NEEDED) fprintf(stderr, "workspace too small: %zu < %zu\n", ws_size, (size_t)WS_NEEDED);
  }
  Params p{};
  const float** pp = (const float**)&p;
  for (int i = 0; i < 26; ++i) pp[i] = (const float*)d_in[i];
  p.out = (float*)d_out;
  p.ws = (char*)d_ws;
  p.phase_lo = 0;
  p.phase_hi = 22;
  (void)hipMemsetAsync((char*)d_ws + OFF_BAR, 0, XCD_BAR_WORDS * 4, stream);
  void* args[] = {&p};
  hipError_t e = hipLaunchCooperativeKernel((void*)mega, dim3(grid_blocks), dim3(NTHR), args, 0, stream);
  if (e != hipSuccess) fprintf(stderr, "cooperative launch failed: %s (grid %d)\n", hipGetErrorString(e), grid_blocks);
}
```

```cpp
#include <hip/hip_runtime.h>
#include <hip/hip_cooperative_groups.h>
#include <stdint.h>
#include <stdio.h>
namespace cg = cooperative_groups;

typedef unsigned short u16;
typedef __attribute__((ext_vector_type(8))) short bf16x8;
typedef __attribute__((ext_vector_type(16))) float f32x16;
typedef __bf16 bf16x2_t __attribute__((ext_vector_type(2)));
typedef float f2_t __attribute__((ext_vector_type(2)));

#define DEV __device__ __forceinline__

constexpr int R = 16896;
constexpr int RB = 8448;
constexpr int PW = 4096;
constexpr int C_Q = 0, C_K = 512, C_BG = 768, C_CG = 1280, C_U = 1792, C_PU = 2304, C_Z = 2816, C_XS = 3328, C_BM = 3840, C_CM = 3968;
constexpr int C_YM = 1280;
constexpr int NTHR = 256;
constexpr int SMEM_BYTES = 77824;

constexpr size_t OFF_WT_IN = 0;
constexpr size_t OFF_WT_BR = OFF_WT_IN + (size_t)8208 * 1024 * 2;
constexpr size_t OFF_WT_OUT = OFF_WT_BR + (size_t)4 * 1024 * 512 * 2;
constexpr size_t OFF_WT_UP = OFF_WT_OUT + (size_t)1024 * 1024 * 2;
constexpr size_t OFF_WT_DOWN = OFF_WT_UP + (size_t)5632 * 1024 * 2;
constexpr size_t OFF_H = OFF_WT_DOWN + (size_t)1024 * 2816 * 2;
constexpr size_t OFF_P = OFF_H + (size_t)R * 1024 * 2;
constexpr size_t OFF_VT = OFF_P + (size_t)R * PW * 2;
constexpr size_t OFF_POOLED = OFF_VT + (size_t)4 * 64 * RB * 2;
constexpr size_t OFF_S = OFF_POOLED + (size_t)R * 512 * 2;
constexpr size_t OFF_XC = OFF_S + (size_t)32 * 66 * 4096 * 4;
constexpr size_t OFF_DT = OFF_XC + (size_t)512 * 1024 * 4;
constexpr size_t OFF_SSQ = OFF_DT + (size_t)R * 16 * 4;
constexpr size_t OFF_DECAY = OFF_SSQ + (size_t)R * 8 * 4;
constexpr size_t OFF_MOD = OFF_DECAY + (size_t)32 * 66 * 4 + 256;
constexpr size_t OFF_ROPE = OFF_MOD + (size_t)2 * 3 * 6144 * 4;
constexpr size_t OFF_BAR = OFF_ROPE + (size_t)2 * 128 * 16 * 4;
constexpr size_t WS_NEEDED = OFF_BAR + 3456 * 4;

struct Params {
  const float *x, *c, *ctx, *c_ctx, *w_mod, *b_mod, *norm_mix, *w_in, *q_norm, *k_norm, *conv_short, *pool_w, *pool_scale,
      *ssd_conv_w, *ssd_conv_b, *ssd_dt_bias, *ssd_a_log, *ssd_d, *ssd_norm, *w_branch, *w_out, *norm_ffn, *w_up, *ffn_conv,
      *w_down, *final_norm;
  float* out;
  char* ws;
  int phase_lo, phase_hi;
};

DEV int tid() { int t = __builtin_amdgcn_workitem_id_x(); asm volatile("" : "+v"(t)); return t; }
DEV int bid() { int b = __builtin_amdgcn_workgroup_id_x(); asm volatile("" : "+s"(b)); return b; }
DEV unsigned pack2(float a, float b) {
  f2_t v = {a, b};
  bf16x2_t r = __builtin_convertvector(v, bf16x2_t);
  return *(unsigned*)&r;
}
DEV u16 f2bf(float a) { return (u16)(pack2(a, 0.f) & 0xffff); }
DEV float bf2f(u16 h) { return __uint_as_float(((unsigned)h) << 16); }
DEV float bflo(unsigned u) { return __uint_as_float(u << 16); }
DEV float bfhi(unsigned u) { return __uint_as_float(u & 0xffff0000u); }
DEV float silu_f(float v) { return v * __builtin_amdgcn_rcpf(1.f + __expf(-v)); }
DEV float sigmoid_f(float v) { return __builtin_amdgcn_rcpf(1.f + __expf(-v)); }
DEV void unpack8(uint4 u, float* f) {
  f[0] = bflo(u.x); f[1] = bfhi(u.x); f[2] = bflo(u.y); f[3] = bfhi(u.y);
  f[4] = bflo(u.z); f[5] = bfhi(u.z); f[6] = bflo(u.w); f[7] = bfhi(u.w);
}
DEV uint4 pack8(const float* f) {
  uint4 u; u.x = pack2(f[0], f[1]); u.y = pack2(f[2], f[3]); u.z = pack2(f[4], f[5]); u.w = pack2(f[6], f[7]);
  return u;
}
DEV bf16x8 as_bf16x8(uint4 u) { union { uint4 a; bf16x8 b; } x; x.a = u; return x.b; }
DEV f32x16 mfma32(bf16x8 a, bf16x8 b, f32x16 c) { return __builtin_amdgcn_mfma_f32_32x32x16_bf16(a, b, c, 0, 0, 0); }
DEV int rowmap(int reg, int h) { return (reg & 3) + 8 * (reg >> 2) + 4 * h; }

DEV const float* xin_row(const Params& p, int r) {
  int b = r / RB, rr = r - b * RB;
  return rr < 256 ? p.ctx + ((size_t)(b * 256 + rr)) * 1024 : p.x + ((size_t)(b * 8192 + rr - 256)) * 1024;
}
DEV float* xres_row(const Params& p, int r) {
  int b = r / RB, rr = r - b * RB;
  return rr < 256 ? (float*)(p.ws + OFF_XC) + ((size_t)(b * 256 + rr)) * 1024 : p.out + ((size_t)(b * 8192 + rr - 256)) * 1024;
}
DEV int cond_of_row(int r) { int b = r / RB; return (r - b * RB) < 256 ? 2 : b; }

DEV bool tile_map(int j, int x, int Mt, int Nt, int& mt, int& nt) {
  int Mx = (Mt - x + 7) >> 3;
  int total = Mx * Nt;
  if (j >= total) return false;
  int full = Nt >> 3, per_full = Mx * 8;
  int mi, n;
  if (j < full * per_full) { int c = j / per_full; int rem = j - c * per_full; mi = rem >> 3; n = c * 8 + (rem & 7); }
  else { int rem = j - full * per_full; int wl = Nt - full * 8; mi = rem / wl; n = full * 8 + (rem - mi * wl); }
  mt = x + 8 * mi; nt = n;
  return true;
}

#define LAS3 __attribute__((address_space(3)))
template <int MI, int NI>
DEV void gemm_core(const u16* __restrict__ A, int lda, int arow0, int amax, const u16* __restrict__ Bt, int ldb, int brow0,
                   int brow1, int K, f32x16 (&acc)[MI][NI], char* smem) {
  const int t = tid(), lane = t & 63, w = t >> 6, wr = w >> 1, wc = w & 1, r = lane & 31, h = lane >> 5;
  constexpr int ASB = 4096 * MI, STB = 4096 * (MI + NI);
  const int lrow = lane >> 2, lp = lane & 3;
  unsigned oa[MI], ob[NI];
#pragma unroll
  for (int i = 0; i < MI; ++i) {
    int R_ = (w * MI + i) * 16 + lrow;
    int ar_ = arow0 + R_; ar_ = ar_ < 0 ? 0 : (ar_ > amax ? amax : ar_);
    oa[i] = (unsigned)ar_ * (unsigned)lda + (unsigned)((lp ^ ((R_ >> 2) & 3)) * 8);
  }
#pragma unroll
  for (int i = 0; i < NI; ++i) {
    int R_ = (w * NI + i) * 16 + lrow;
    int br_ = R_ < 64 ? brow0 + R_ : brow1 + R_ - 64;
    ob[i] = (unsigned)br_ * (unsigned)ldb + (unsigned)((lp ^ ((R_ >> 2) & 3)) * 8);
  }
  const int wu = __builtin_amdgcn_readfirstlane(w);
  char* sA_w = smem + wu * (1024 * MI);
  char* sB_w = smem + ASB + wu * (1024 * NI);
#pragma unroll
  for (int i = 0; i < MI; ++i) oa[i] *= 2u;
#pragma unroll
  for (int i = 0; i < NI; ++i) ob[i] *= 2u;
#define GLDS(stg, k0)                                                                                                    \
  {                                                                                                                      \
    char* da_ = sA_w + (stg) * STB;                                                                                      \
    char* db_ = sB_w + (stg) * STB;                                                                                      \
    const char* ga_ = (const char*)(A + (k0));                                                                           \
    const char* gb_ = (const char*)(Bt + (k0));                                                                          \
    _Pragma("unroll") for (int i = 0; i < MI; ++i)                                                                       \
        __builtin_amdgcn_global_load_lds((const void*)(ga_ + oa[i]), (LAS3 void*)(da_ + i * 1024), 16, 0, 0);            \
    _Pragma("unroll") for (int i = 0; i < NI; ++i)                                                                       \
        __builtin_amdgcn_global_load_lds((const void*)(gb_ + ob[i]), (LAS3 void*)(db_ + i * 1024), 16, 0, 0);            \
  }
  const int sw = (r >> 2) & 3;
  const int co0 = ((0 + h) ^ sw) << 4, co1 = ((2 + h) ^ sw) << 4;
  const int arow_b = (wr * 32 * MI + r) * 64;
  const int brow_b = ASB + (wc * 32 * NI + r) * 64;
  const int nk = K >> 5;
  GLDS(0, 0);
  GLDS(1, 32);
  int st = 0;
  for (int kt = 0; kt < nk; ++kt) {
    if (kt + 1 < nk) {
      if (MI + NI == 6) asm volatile("s_waitcnt vmcnt(6)" ::: "memory");
      else if (MI + NI == 4) asm volatile("s_waitcnt vmcnt(4)" ::: "memory");
      else if (MI + NI == 2) asm volatile("s_waitcnt vmcnt(2)" ::: "memory");
      else asm volatile("s_waitcnt vmcnt(3)" ::: "memory");
    } else {
      asm volatile("s_waitcnt vmcnt(0)" ::: "memory");
    }
    __builtin_amdgcn_s_barrier();
    asm volatile("" ::: "memory");
    if (kt + 2 < nk) {
      int s2 = st + 2; s2 = s2 >= 3 ? s2 - 3 : s2;
      GLDS(s2, (kt + 2) << 5);
    }
    const char* cur = smem + st * STB;
#pragma unroll
    for (int ks = 0; ks < 2; ++ks) {
      const int co = ks == 0 ? co0 : co1;
      bf16x8 fb[NI];
#pragma unroll
      for (int ni = 0; ni < NI; ++ni) fb[ni] = *(const bf16x8*)(cur + brow_b + ni * 2048 + co);
#pragma unroll
      for (int mi = 0; mi < MI; ++mi) {
        bf16x8 fa = *(const bf16x8*)(cur + arow_b + mi * 2048 + co);
#pragma unroll
        for (int ni = 0; ni < NI; ++ni) acc[mi][ni] = mfma32(fa, fb[ni], acc[mi][ni]);
      }
    }
    st = st == 2 ? 0 : st + 1;
  }
  __syncthreads();
#undef GLDS
}

template <int MI, int NI>
DEV void zero_accm(f32x16 (&acc)[MI][NI]) {
#pragma unroll
  for (int a = 0; a < MI; ++a)
#pragma unroll
    for (int b = 0; b < NI; ++b)
#pragma unroll
      for (int i = 0; i < 16; ++i) acc[a][b][i] = 0.f;
}
template <int NI>
DEV void zero_acc(f32x16 (&acc)[2][NI]) { zero_accm<2, NI>(acc); }

DEV void mod_item(const Params& p, int item, char* smem) {
  int layer = item / 192, cgp = item - layer * 192;
  int t = tid(), kq = t >> 3, cq = t & 7;
  float* ssil = (float*)smem;
  float* red = ssil + 3 * 1024;
#pragma unroll
  for (int i = t; i < 3072; i += NTHR) {
    int a = i >> 10, k = i & 1023;
    float cv = a == 0 ? p.c[k] : (a == 1 ? p.c[1024 + k] : p.c_ctx[k]);
    ssil[i] = silu_f(cv);
  }
  __syncthreads();
  int col = cgp * 32 + cq * 4;
  const float* W = p.w_mod + (size_t)layer * 1024 * 6144 + col;
  float acc[3][4];
#pragma unroll
  for (int a = 0; a < 3; ++a)
#pragma unroll
    for (int b = 0; b < 4; ++b) acc[a][b] = 0.f;
#pragma unroll 1
  for (int k0 = kq * 32; k0 < kq * 32 + 32; k0 += 8) {
    float4 wv[8];
#pragma unroll
    for (int j = 0; j < 8; ++j) wv[j] = *(const float4*)(W + (size_t)(k0 + j) * 6144);
#pragma unroll
    for (int j = 0; j < 8; ++j) {
#pragma unroll
      for (int a = 0; a < 3; ++a) {
        float sv = ssil[a * 1024 + k0 + j];
        acc[a][0] += sv * wv[j].x; acc[a][1] += sv * wv[j].y; acc[a][2] += sv * wv[j].z; acc[a][3] += sv * wv[j].w;
      }
    }
  }
#pragma unroll
  for (int a = 0; a < 3; ++a)
#pragma unroll
    for (int b = 0; b < 4; ++b) red[(kq * 3 + a) * 32 + cq * 4 + b] = acc[a][b];
  __syncthreads();
  if (t < 96) {
    int a = t >> 5, cc = t & 31;
    float sum = 0.f;
    for (int q = 0; q < 32; ++q) sum += red[(q * 3 + a) * 32 + cc];
    int cg = cgp * 32 + cc;
    float* mod = (float*)(p.ws + OFF_MOD);
    mod[(layer * 3 + a) * 6144 + cg] = sum + p.b_mod[layer * 6144 + cg];
  }
  __syncthreads();
}

DEV void convT_tile(const float* __restrict__ src, int K, int N, u16* __restrict__ dst, int ldd, const float* __restrict__ kscale,
                    int tk, int tn, char* smem) {
  float* tile = (float*)smem;
  int t = tid();
  int n4 = (t & 15) * 4, kk = t >> 4;
  float4 v[4];
#pragma unroll
  for (int i = 0; i < 4; ++i) {
    int gn = tn * 64 + n4, gk = tk * 64 + kk + 16 * i;
    v[i] = gn < N ? *(const float4*)(src + (size_t)gk * N + gn) : make_float4(0.f, 0.f, 0.f, 0.f);
  }
#pragma unroll
  for (int i = 0; i < 4; ++i) {
    int k = kk + 16 * i;
    float sc = kscale ? kscale[tk * 64 + k] : 1.f;
    tile[k * 65 + n4] = v[i].x * sc; tile[k * 65 + n4 + 1] = v[i].y * sc;
    tile[k * 65 + n4 + 2] = v[i].z * sc; tile[k * 65 + n4 + 3] = v[i].w * sc;
  }
  __syncthreads();
  int wn = t >> 2, ks = (t & 3) * 16;
  int gn = tn * 64 + wn;
  if (gn < N) {
    float f[16];
#pragma unroll
    for (int i = 0; i < 16; ++i) f[i] = tile[(ks + i) * 65 + wn];
    uint4 u0 = pack8(f), u1 = pack8(f + 8);
    u16* d = dst + (size_t)gn * ldd + tk * 64 + ks;
    *(uint4*)d = u0;
    *(uint4*)(d + 8) = u1;
  }
  __syncthreads();
}

DEV void poolfold_item(const Params& p, int layer, int item, char* smem) {
  int g = item >> 6, nt = (item >> 2) & 15, cq = item & 3;
  int t = tid(), nl = t & 63, jq = t >> 6, n = nt * 64 + nl;
  float* sWp = (float*)smem;
  float* red = sWp + 32 * 128;
  const float* Wp = p.pool_w + ((size_t)(layer * 4 + g)) * 128 * 128 + (size_t)cq * 32 * 128;
  for (int i = t; i < 1024; i += NTHR) *(float4*)(sWp + i * 4) = *(const float4*)(Wp + i * 4);
  __syncthreads();
  const float* Wb = p.w_branch + ((size_t)(layer * 4 + 2)) * 512 * 1024 + (size_t)(g * 128 + jq * 32) * 1024 + n;
  const float* sc = p.pool_scale + layer * 512 + g * 128 + jq * 32;
  float wb[32];
#pragma unroll
  for (int j = 0; j < 32; ++j) wb[j] = Wb[(size_t)j * 1024] * sc[j];
  float acc[32];
#pragma unroll
  for (int i = 0; i < 32; ++i) {
    float a = 0.f;
#pragma unroll
    for (int j4 = 0; j4 < 8; ++j4) {
      float4 w4 = *(const float4*)(sWp + i * 128 + jq * 32 + j4 * 4);
      a += w4.x * wb[j4 * 4] + w4.y * wb[j4 * 4 + 1] + w4.z * wb[j4 * 4 + 2] + w4.w * wb[j4 * 4 + 3];
    }
    acc[i] = a;
  }
#pragma unroll
  for (int i = 0; i < 32; ++i) red[(jq * 32 + i) * 64 + nl] = acc[i];
  __syncthreads();
  {
    int on = t >> 2, c0 = (t & 3) * 8;
    float v[8];
#pragma unroll
    for (int i = 0; i < 8; ++i)
      v[i] = red[(0 * 32 + c0 + i) * 64 + on] + red[(1 * 32 + c0 + i) * 64 + on] + red[(2 * 32 + c0 + i) * 64 + on] + red[(3 * 32 + c0 + i) * 64 + on];
    u16* dst = (u16*)(p.ws + OFF_WT_BR) + (size_t)2 * 1024 * 512 + (size_t)(nt * 64 + on) * 512 + g * 128 + cq * 32 + c0;
    *(uint4*)dst = pack8(v);
  }
  __syncthreads();
}

DEV void convert_weights(const Params& p, int layer, int part, char* smem) {
  const int n_in = 16 * 129, n_br = 3 * 8 * 16, n_out = 16 * 16, n_up = 16 * 88, n_dn = 44 * 16, n_pf = 256;
  const int total = n_in + n_br + n_out + n_up + n_dn + n_pf;
  const int it0 = part == 0 ? 0 : n_in, it1 = part == 0 ? n_in : total;
  for (int it = it0 + bid(); it < it1; it += gridDim.x) {
    int i = it;
    if (i < n_in) {
      convT_tile(p.w_in + (size_t)layer * 1024 * 8208, 1024, 8208, (u16*)(p.ws + OFF_WT_IN), 1024, nullptr, i & 15, i >> 4, smem);
      continue;
    }
    i -= n_in;
    if (i < n_br) {
      int kb = i / 128, rem = i - kb * 128;
      int br = kb == 2 ? 3 : kb;
      convT_tile(p.w_branch + ((size_t)(layer * 4 + br)) * 512 * 1024, 512, 1024,
                 (u16*)(p.ws + OFF_WT_BR) + (size_t)br * 1024 * 512, 512, br == 3 ? p.ssd_norm + layer * 512 : nullptr, rem & 7,
                 rem >> 3, smem);
      continue;
    }
    i -= n_br;
    if (i < n_out) {
      convT_tile(p.w_out + (size_t)layer * 1024 * 1024, 1024, 1024, (u16*)(p.ws + OFF_WT_OUT), 1024, nullptr, i & 15, i >> 4, smem);
      continue;
    }
    i -= n_out;
    if (i < n_up) {
      convT_tile(p.w_up + (size_t)layer * 1024 * 5632, 1024, 5632, (u16*)(p.ws + OFF_WT_UP), 1024, nullptr, i & 15, i >> 4, smem);
      continue;
    }
    i -= n_up;
    if (i < n_dn) {
      convT_tile(p.w_down + (size_t)layer * 2816 * 1024, 2816, 1024, (u16*)(p.ws + OFF_WT_DOWN), 2816, nullptr, i % 44, i / 44, smem);
      continue;
    }
    i -= n_dn;
    poolfold_item(p, layer, i, smem);
  }
}

DEV void norm_phase(const Params& p, int layer, int which, bool from_input) {
  const int lane = tid() & 63, w = tid() >> 6;
  const float* mod = (const float*)(p.ws + OFF_MOD);
  u16* H = (u16*)(p.ws + OFF_H);
  const int gw = bid() * 4 + w, nw = gridDim.x * 4;
  const float* gn = which == 2 ? p.final_norm : (which == 0 ? p.norm_mix : p.norm_ffn) + layer * 1024;
  float4 g4[4];
#pragma unroll
  for (int i = 0; i < 4; ++i) g4[i] = *(const float4*)(gn + i * 256 + lane * 4);
  for (int r0 = gw; r0 < R; r0 += 4 * nw) {
    int rws[4] = {r0, r0 + nw, r0 + 2 * nw, r0 + 3 * nw};
    float4 v[4][4];
    bool ok[4];
#pragma unroll
    for (int q = 0; q < 4; ++q) {
      int r = rws[q];
      int b = r / RB, rr = r - b * RB;
      ok[q] = r < R && !(which == 2 && rr < 256);
      if (ok[q]) {
        const float* xr = from_input ? xin_row(p, r) : xres_row(p, r);
#pragma unroll
        for (int i = 0; i < 4; ++i) v[q][i] = *(const float4*)(xr + i * 256 + lane * 4);
      } else {
#pragma unroll
        for (int i = 0; i < 4; ++i) v[q][i] = make_float4(0.f, 0.f, 0.f, 0.f);
      }
    }
    float ss[4];
#pragma unroll
    for (int q = 0; q < 4; ++q) {
      ss[q] = 0.f;
#pragma unroll
      for (int i = 0; i < 4; ++i) ss[q] += v[q][i].x * v[q][i].x + v[q][i].y * v[q][i].y + v[q][i].z * v[q][i].z + v[q][i].w * v[q][i].w;
    }
#pragma unroll
    for (int o = 32; o >= 1; o >>= 1) { ss[0] += __shfl_xor(ss[0], o); ss[1] += __shfl_xor(ss[1], o); ss[2] += __shfl_xor(ss[2], o); ss[3] += __shfl_xor(ss[3], o); }
#pragma unroll
    for (int q = 0; q < 4; ++q) {
      if (!ok[q]) continue;
      int r = rws[q];
      int b = r / RB, rr = r - b * RB;
      float rstd = rsqrtf(ss[q] * (1.f / 1024.f) + 1e-6f);
      if (which == 2) {
        float* o = p.out + ((size_t)(b * 8192 + rr - 256)) * 1024;
#pragma unroll
        for (int i = 0; i < 4; ++i) {
          float4 y; y.x = v[q][i].x * rstd * g4[i].x; y.y = v[q][i].y * rstd * g4[i].y; y.z = v[q][i].z * rstd * g4[i].z; y.w = v[q][i].w * rstd * g4[i].w;
          *(float4*)(o + i * 256 + lane * 4) = y;
        }
      } else {
        if (from_input && r >= 16384) {
          float* xo = xres_row(p, r);
#pragma unroll
          for (int i = 0; i < 4; ++i) *(float4*)(xo + i * 256 + lane * 4) = v[q][i];
        }
        int cond = rr < 256 ? 2 : b;
        const float* mb = mod + (size_t)(layer * 3 + cond) * 6144 + (which == 0 ? 0 : 3072);
#pragma unroll
        for (int i = 0; i < 4; ++i) {
          int c0 = i * 256 + lane * 4;
          float4 sh = *(const float4*)(mb + c0);
          float4 sc = *(const float4*)(mb + 1024 + c0);
          float y0 = v[q][i].x * rstd * g4[i].x * (1.f + sc.x) + sh.x;
          float y1 = v[q][i].y * rstd * g4[i].y * (1.f + sc.y) + sh.y;
          float y2 = v[q][i].z * rstd * g4[i].z * (1.f + sc.z) + sh.z;
          float y3 = v[q][i].w * rstd * g4[i].w * (1.f + sc.w) + sh.w;
          uint2 u; u.x = pack2(y0, y1); u.y = pack2(y2, y3);
          *(uint2*)(H + (size_t)r * 1024 + c0) = u;
        }
      }
    }
  }
}

DEV void inproj_phase(const Params& p, int layer, char* smem) {
  constexpr int MI = 2;
  u16* P = (u16*)(p.ws + OFF_P);
  const u16* H = (const u16*)(p.ws + OFF_H);
  const u16* WT = (const u16*)(p.ws + OFF_WT_IN);
  const float* cosT = (const float*)(p.ws + OFF_ROPE);
  const float* sinT = cosT + 128 * 16;
  const int x = bid() & 7, lb = bid() >> 3, nl = gridDim.x >> 3;
  int mt, nt;
  for (int j = lb; tile_map(j, x, R / (64 * MI), 33, mt, nt); j += nl) {
    const int t = tid(), lane = t & 63, w = t >> 6, wr = w >> 1, wc = w & 1, r = lane & 31, h = lane >> 5;
    f32x16 acc[MI][2];
    zero_accm<MI, 2>(acc);
    const int m0 = mt * (64 * MI);
    gemm_core<MI, 2>(H, 1024, m0, R - 1, WT, 1024, nt * 128, nt * 128 + 64, 1024, acc, smem);
    const int lrow0 = wr * (32 * MI) + 4 * h;
    if (nt < 5) {
      const float* gain = (nt < 4 ? p.q_norm : p.k_norm) + layer * 64;
      const float g0 = gain[r], g1 = gain[32 + r];
      const float qs = nt < 4 ? 0.125f * 1.4426950408889634f : 1.0f;
      const bool is_ctx = (m0 % RB) < 256;
      u16* tb = P + (size_t)m0 * PW + nt * 128 + wc * 64;
      const int tt0 = (m0 % RB) - 256 + lrow0;
      const int f = r & 15;
#pragma unroll
      for (int mi = 0; mi < MI; ++mi)
#pragma unroll
        for (int rg8 = 0; rg8 < 2; ++rg8) {
          float tc0[8], ts0[8], tc1[8], ts1[8];
#pragma unroll
          for (int e = 0; e < 8; ++e) {
            const int reg = rg8 * 8 + e;
            const int lr = mi * 32 + (reg & 3) + 8 * (reg >> 2);
            int tt = is_ctx ? 0 : tt0 + lr;
            int prow = tt >> 6, pcol = tt & 63;
            tc0[e] = cosT[prow * 16 + f]; ts0[e] = sinT[prow * 16 + f]; tc1[e] = cosT[pcol * 16 + f]; ts1[e] = sinT[pcol * 16 + f];
          }
#pragma unroll
          for (int e = 0; e < 8; ++e) {
            const int reg = rg8 * 8 + e;
            const int lr = mi * 32 + (reg & 3) + 8 * (reg >> 2);
            float v0 = acc[mi][0][reg], v1 = acc[mi][1][reg];
            float ss = v0 * v0 + v1 * v1;
#pragma unroll
            for (int o = 16; o >= 1; o >>= 1) ss += __shfl_xor(ss, o);
            float rstd = rsqrtf(ss * (1.f / 64.f) + 1e-6f);
            v0 = v0 * rstd * g0; v1 = v1 * rstd * g1;
            if (!is_ctx) {
              float p0 = __shfl_xor(v0, 16), p1 = __shfl_xor(v1, 16);
              if (r < 16) { v0 = v0 * tc0[e] - p0 * ts0[e]; v1 = v1 * tc1[e] - p1 * ts1[e]; }
              else { v0 = p0 * ts0[e] + v0 * tc0[e]; v1 = p1 * ts1[e] + v1 * tc1[e]; }
            }
            unsigned off = (unsigned)(lrow0 + lr) * PW + r;
            tb[off] = f2bf(v0 * qs);
            tb[off + 32] = f2bf(v1 * qs);
          }
          __builtin_amdgcn_sched_barrier(0);
        }
    } else if (nt == 5) {
      const int b = m0 / RB, rr0 = m0 - b * RB + lrow0;
      u16* tb = (u16*)(p.ws + OFF_VT) + (size_t)((b * 2 + wc) * 64) * RB;
#pragma unroll
      for (int mi = 0; mi < MI; ++mi)
#pragma unroll
        for (int ni = 0; ni < 2; ++ni)
#pragma unroll
          for (int q = 0; q < 4; ++q) {
            const int T0 = rr0 + mi * 32 + 8 * q;
            const int gi = (T0 >> 2) & 3;
            const int Tp = (T0 & ~15) + 4 * (gi == 1 ? 2 : (gi == 2 ? 1 : gi));
            unsigned off = (unsigned)(ni * 32 + r) * RB + Tp;
            uint2 u; u.x = pack2(acc[mi][ni][4 * q], acc[mi][ni][4 * q + 1]); u.y = pack2(acc[mi][ni][4 * q + 2], acc[mi][ni][4 * q + 3]);
            *(uint2*)(tb + off) = u;
          }
    } else if (nt < 32) {
      u16* tb = P + (size_t)m0 * PW + nt * 128 + wc * 64;
#pragma unroll
      for (int mi = 0; mi < MI; ++mi)
#pragma unroll
        for (int reg = 0; reg < 16; ++reg) {
          unsigned off = (unsigned)(lrow0 + mi * 32 + (reg & 3) + 8 * (reg >> 2)) * PW + r;
          tb[off] = f2bf(acc[mi][0][reg]);
          tb[off + 32] = f2bf(acc[mi][1][reg]);
          if ((reg & 3) == 3) __builtin_amdgcn_sched_barrier(0);
        }
    } else {
      if (wc == 0 && r < 16) {
        float* tb = (float*)(p.ws + OFF_DT) + (size_t)m0 * 16;
        float bias = p.ssd_dt_bias[layer * 16 + r];
#pragma unroll
        for (int mi = 0; mi < MI; ++mi)
#pragma unroll
          for (int reg = 0; reg < 16; ++reg) {
            unsigned off = (unsigned)(lrow0 + mi * 32 + (reg & 3) + 8 * (reg >> 2)) * 16 + r;
            float v = acc[mi][0][reg] + bias;
            float ev = __expf(-fabsf(v));
            float l1 = ev < 0.01f ? ev * (1.f - ev * (0.5f - ev * (1.f / 3.f))) : __logf(1.f + ev);
            tb[off] = fmaxf(v, 0.f) + l1;
            if ((reg & 3) == 3) __builtin_amdgcn_sched_barrier(0);
          }
      }
    }
  }
}

DEV void seq_of_row(int row, int& lo, int& n, int& tt) {
  int b = row / RB, rr = row - b * RB;
  if (rr < 256) { lo = row - rr; n = 256; tt = rr; }
  else { lo = row - rr + 256; n = 8192; tt = rr - 256; }
}
DEV void pooled_item(const Params& p, int it) {
  const u16* P = (const u16*)(p.ws + OFF_P);
  u16* PO = (u16*)(p.ws + OFF_POOLED);
  int t = tid();
  int row = it * 4 + (t >> 6), ch = t & 63;
  int g = ch >> 4, half = 1 << g;
  int lo, n, tt;
  seq_of_row(row, lo, n, tt);
  int a = tt - half < 0 ? 0 : tt - half, bq = tt + half > n ? n : tt + half;
  const u16* base = P + (size_t)lo * PW + C_PU + ch * 8;
  uint4 u[16];
#pragma unroll
  for (int q = 0; q < 16; ++q) {
    int rq = a + q;
    u[q] = rq < bq ? *(const uint4*)(base + (size_t)rq * PW) : make_uint4(0u, 0u, 0u, 0u);
  }
  uint4 us = *(const uint4*)(base + (size_t)tt * PW);
  float s[8];
#pragma unroll
  for (int i = 0; i < 8; ++i) s[i] = 0.f;
#pragma unroll
  for (int q = 0; q < 16; ++q) {
    float f[8]; unpack8(u[q], f);
#pragma unroll
    for (int i = 0; i < 8; ++i) s[i] += f[i];
  }
  float f[8]; unpack8(us, f);
  float inv = 1.f / (float)(bq - a);
#pragma unroll
  for (int i = 0; i < 8; ++i) s[i] = s[i] * inv - f[i];
  *(uint4*)(PO + (size_t)row * 512 + ch * 8) = pack8(s);
}
DEV void sconv_item(const Params& p, int layer, int it) {
  u16* P = (u16*)(p.ws + OFF_P);
  int t = tid();
  int row = it * 4 + (t >> 6), ch = t & 63;
  int lo, n, tt;
  seq_of_row(row, lo, n, tt);
  const float* wc = p.conv_short + layer * 3 * 512 + ch * 8;
  float accv[8];
#pragma unroll
  for (int i = 0; i < 8; ++i) accv[i] = 0.f;
#pragma unroll
  for (int d = -1; d <= 1; ++d) {
    int q = tt + d;
    if (q < 0 || q >= n) continue;
    uint4 ucg = *(const uint4*)(P + (size_t)(lo + q) * PW + C_CG + ch * 8);
    uint4 uu = *(const uint4*)(P + (size_t)(lo + q) * PW + C_U + ch * 8);
    float a[8], b[8]; unpack8(ucg, a); unpack8(uu, b);
    const float* wv = wc + (d + 1) * 512;
#pragma unroll
    for (int i = 0; i < 8; ++i) accv[i] += wv[i] * (a[i] * b[i]);
  }
  uint4 ubg = *(const uint4*)(P + (size_t)row * PW + C_BG + ch * 8);
  float bg[8]; unpack8(ubg, bg);
#pragma unroll
  for (int i = 0; i < 8; ++i) accv[i] *= bg[i];
  *(uint4*)(P + (size_t)row * PW + C_BG + ch * 8) = pack8(accv);
}

struct StageRegs { uint4 u0[4], um[4], up[4]; };
DEV StageRegs ssd_stage_load(const Params& p, int r0, bool has_prev, bool has_next, int col0) {
  const u16* P = (const u16*)(p.ws + OFF_P);
  int t = tid(), s = t & 127, half = t >> 7;
  const bool pm = s > 0 || has_prev, pp = s < 127 || has_next;
  const u16* base = P + (size_t)(r0 + s) * PW + col0 + half * 8;
  StageRegs rg;
#pragma unroll
  for (int j = 0; j < 4; ++j) {
    rg.u0[j] = *(const uint4*)(base + j * 16);
    rg.um[j] = pm ? *(const uint4*)(base + j * 16 - PW) : make_uint4(0u, 0u, 0u, 0u);
    rg.up[j] = pp ? *(const uint4*)(base + j * 16 + PW) : make_uint4(0u, 0u, 0u, 0u);
  }
  return rg;
}
DEV void ssd_stage_put(const Params& p, int layer, const StageRegs& rg, int col0, u16* dst, bool transposed, int stride) {
  int t = tid(), s = t & 127, half = t >> 7;
  const float* cw = p.ssd_conv_w + layer * 3 * 768 + (col0 - C_XS);
  const float* cb = p.ssd_conv_b + layer * 768 + (col0 - C_XS);
#pragma unroll
  for (int j = 0; j < 4; ++j) {
    const int cc = half + 2 * j;
    float x0[8], xm[8], xp[8];
    unpack8(rg.u0[j], x0); unpack8(rg.um[j], xm); unpack8(rg.up[j], xp);
    float v[8];
#pragma unroll
    for (int i = 0; i < 8; ++i) {
      int c = cc * 8 + i;
      float a = cw[c] * xm[i] + cw[768 + c] * x0[i] + cw[1536 + c] * xp[i] + cb[c];
      v[i] = silu_f(a);
    }
    if (!transposed) *(uint4*)(dst + s * stride + cc * 8) = pack8(v);
    else {
#pragma unroll
      for (int i = 0; i < 8; ++i) dst[(cc * 8 + i) * stride + s] = f2bf(v[i]);
    }
  }
}

DEV void ssd_acum(const Params& p, int layer, int r0, int head, int d, int lane, float* acum, float* dts, float& total) {
  const float* DT = (const float*)(p.ws + OFF_DT);
  float arate = -__expf(p.ssd_a_log[layer * 16 + d * 8 + head]);
  int n0 = d == 0 ? 2 * lane : 127 - 2 * lane;
  int n1 = d == 0 ? 2 * lane + 1 : 126 - 2 * lane;
  float dt0 = DT[(size_t)(r0 + n0) * 16 + d * 8 + head], dt1 = DT[(size_t)(r0 + n1) * 16 + d * 8 + head];
  float a0 = dt0 * arate, a1 = dt1 * arate;
  float s = a0 + a1;
#pragma unroll
  for (int o = 1; o < 64; o <<= 1) {
    float tv = __shfl_up(s, o);
    if (lane >= o) s += tv;
  }
  acum[n1] = s; acum[n0] = s - a1;
  dts[n0] = dt0; dts[n1] = dt1;
  total = __shfl(s, 63);
}

constexpr int ST = 136;
DEV void ssd1_item(const Params& p, int layer, int item, char* smem) {
  int b = item / (66 * 8), rem = item - b * 66 * 8, nc = rem >> 3, head = rem & 7, g = head >> 2;
  int r0 = b * RB + nc * 128;
  bool has_prev = !(nc == 0 || nc == 2), has_next = !(nc == 1 || nc == 65);
  u16* sBT = (u16*)smem;
  u16* sXT = sBT + 64 * ST;
  float* sW = (float*)(sXT + 64 * ST);
  float* sA = sW + 256;
  float* sD = sA + 256;
  int t = tid(), lane = t & 63, w = t >> 6, r = lane & 31, h = lane >> 5;
  {
    StageRegs rb = ssd_stage_load(p, r0, has_prev, has_next, C_BM + g * 64);
    StageRegs rx = ssd_stage_load(p, r0, has_prev, has_next, C_XS + head * 64);
    ssd_stage_put(p, layer, rb, C_BM + g * 64, sBT, true, ST);
    ssd_stage_put(p, layer, rx, C_XS + head * 64, sXT, true, ST);
  }
  if (w < 2) {
    float total;
    ssd_acum(p, layer, r0, head, w, lane, sA + w * 128, sD + w * 128, total);
    __builtin_amdgcn_fence(__ATOMIC_RELEASE, "wavefront");
    int n0 = 2 * lane, n1 = 2 * lane + 1;
    sW[w * 128 + n0] = __expf(total - sA[w * 128 + n0]) * sD[w * 128 + n0];
    sW[w * 128 + n1] = __expf(total - sA[w * 128 + n1]) * sD[w * 128 + n1];
    if (lane == 0) ((float*)(p.ws + OFF_DECAY))[((b * 2 + w) * 8 + head) * 66 + nc] = __expf(total);
  }
  __syncthreads();
  int d = w >> 1, pt = w & 1;
  f32x16 acc[2];
#pragma unroll
  for (int i = 0; i < 16; ++i) { acc[0][i] = 0.f; acc[1][i] = 0.f; }
#pragma unroll
  for (int kk = 0; kk < 8; ++kk) {
    int s0 = kk * 16 + h * 8;
    uint4 ua = *(const uint4*)(sXT + (pt * 32 + r) * ST + s0);
    float f[8]; unpack8(ua, f);
    float4 w0 = *(const float4*)(sW + d * 128 + s0), w1 = *(const float4*)(sW + d * 128 + s0 + 4);
    f[0] *= w0.x; f[1] *= w0.y; f[2] *= w0.z; f[3] *= w0.w; f[4] *= w1.x; f[5] *= w1.y; f[6] *= w1.z; f[7] *= w1.w;
    bf16x8 a = as_bf16x8(pack8(f));
    bf16x8 b0 = *(const bf16x8*)(sBT + r * ST + s0);
    bf16x8 b1 = *(const bf16x8*)(sBT + (32 + r) * ST + s0);
    acc[0] = mfma32(a, b0, acc[0]);
    acc[1] = mfma32(a, b1, acc[1]);
  }
  float* S = (float*)(p.ws + OFF_S) + ((size_t)(((b * 2 + d) * 8 + head) * 66 + nc)) * 4096;
#pragma unroll
  for (int ni = 0; ni < 2; ++ni)
#pragma unroll
    for (int reg = 0; reg < 16; ++reg) S[(pt * 32 + rowmap(reg, h)) * 64 + ni * 32 + r] = acc[ni][reg];
  __syncthreads();
}

DEV void ssd2_phase(const Params& p) {
  float* S = (float*)(p.ws + OFF_S);
  const float* DEC = (const float*)(p.ws + OFF_DECAY);
  for (int i = bid() * NTHR + tid(); i < 32 * 4096; i += gridDim.x * NTHR) {
    int seq = i >> 12, e = i & 4095;
    int d = (seq >> 3) & 1;
    float hst = 0.f;
    float* base = S + (size_t)seq * 66 * 4096 + e;
    const float* dec = DEC + seq * 66;
#pragma unroll 1
    for (int s0 = 0; s0 < 66; s0 += 11) {
      float stv[11];
#pragma unroll
      for (int i = 0; i < 11; ++i) {
        int step = s0 + i;
        int nc = d == 0 ? step : (step < 2 ? 1 - step : 67 - step);
        stv[i] = base[(size_t)nc * 4096];
      }
#pragma unroll
      for (int i = 0; i < 11; ++i) {
        int step = s0 + i;
        int nc = d == 0 ? step : (step < 2 ? 1 - step : 67 - step);
        base[(size_t)nc * 4096] = hst;
        hst = hst * dec[nc] + stv[i];
      }
    }
  }
}

DEV void ssd3_item(const Params& p, int layer, int item, char* smem) {
  int b = item / (66 * 8), rem = item - b * 66 * 8, nc = rem >> 3, head = rem & 7, g = head >> 2;
  int r0 = b * RB + nc * 128;
  bool has_prev = !(nc == 0 || nc == 2), has_next = !(nc == 1 || nc == 65);
  u16* sC = (u16*)smem;
  u16* sB = sC + 128 * 72;
  u16* sXT = sB + 128 * 72;
  u16* sHf = sXT + 64 * ST;
  u16* sHb = sHf + 64 * 72;
  float* sA = (float*)(sHb + 64 * 72);
  float* sD = sA + 256;
  int t = tid(), lane = t & 63, w = t >> 6, r = lane & 31, h = lane >> 5;
  {
    StageRegs rc = ssd_stage_load(p, r0, has_prev, has_next, C_CM + g * 64);
    StageRegs rb = ssd_stage_load(p, r0, has_prev, has_next, C_BM + g * 64);
    const float* S = (const float*)(p.ws + OFF_S);
    const int pp = t >> 2, n0 = (t & 3) * 16;
    float4 hv[2][4];
#pragma unroll
    for (int d = 0; d < 2; ++d) {
      const float* src = S + ((size_t)(((b * 2 + d) * 8 + head) * 66 + nc)) * 4096;
#pragma unroll
      for (int i = 0; i < 4; ++i) hv[d][i] = *(const float4*)(src + pp * 64 + n0 + i * 4);
    }
    ssd_stage_put(p, layer, rc, C_CM + g * 64, sC, false, 72);
    StageRegs rx = ssd_stage_load(p, r0, has_prev, has_next, C_XS + head * 64);
    ssd_stage_put(p, layer, rb, C_BM + g * 64, sB, false, 72);
#pragma unroll
    for (int d = 0; d < 2; ++d) {
      u16* dst = d == 0 ? sHf : sHb;
      float f[16];
#pragma unroll
      for (int i = 0; i < 4; ++i) { f[i * 4] = hv[d][i].x; f[i * 4 + 1] = hv[d][i].y; f[i * 4 + 2] = hv[d][i].z; f[i * 4 + 3] = hv[d][i].w; }
      *(uint4*)(dst + pp * 72 + n0) = pack8(f);
      *(uint4*)(dst + pp * 72 + n0 + 8) = pack8(f + 8);
    }
    ssd_stage_put(p, layer, rx, C_XS + head * 64, sXT, true, ST);
  }
  if (w < 2) {
    float total;
    ssd_acum(p, layer, r0, head, w, lane, sA + w * 128, sD + w * 128, total);
  }
  __syncthreads();
  const int l0 = w * 32;
  bf16x8 cf[4];
#pragma unroll
  for (int kk = 0; kk < 4; ++kk) cf[kk] = *(const bf16x8*)(sC + (l0 + r) * 72 + kk * 16 + h * 8);
  f32x16 X[4];
#pragma unroll
  for (int st = 0; st < 4; ++st) {
#pragma unroll
    for (int i = 0; i < 16; ++i) X[st][i] = 0.f;
#pragma unroll
    for (int kk = 0; kk < 4; ++kk) {
      bf16x8 a = *(const bf16x8*)(sB + (st * 32 + r) * 72 + kk * 16 + h * 8);
      X[st] = mfma32(a, cf[kk], X[st]);
    }
  }
  const int l = l0 + r;
  const float Af_l = sA[l], Ab_l = sA[128 + l];
  f32x16 Y[2];
#pragma unroll
  for (int pt = 0; pt < 2; ++pt)
#pragma unroll
    for (int i = 0; i < 16; ++i) Y[pt][i] = 0.f;
#pragma unroll 1
  for (int d = 0; d < 2; ++d) {
    const u16* sH = d == 0 ? sHf : sHb;
    const float e = __expf(d == 0 ? Af_l : Ab_l);
#pragma unroll
    for (int pt = 0; pt < 2; ++pt) {
      f32x16 T;
#pragma unroll
      for (int i = 0; i < 16; ++i) T[i] = 0.f;
#pragma unroll
      for (int kk = 0; kk < 4; ++kk) {
        bf16x8 af = *(const bf16x8*)(sH + (pt * 32 + r) * 72 + kk * 16 + h * 8);
        T = mfma32(af, cf[kk], T);
      }
#pragma unroll
      for (int i = 0; i < 16; ++i) Y[pt][i] += T[i] * e;
    }
  }
#pragma unroll
  for (int d = 0; d < 2; ++d) {
    const float A_l = d == 0 ? Af_l : Ab_l;
    const float* sAd = sA + d * 128;
    const float* sDd = sD + d * 128;
#pragma unroll
    for (int st = 0; st < 4; ++st) {
      if (d == 0 ? (st > w) : (st < w)) continue;
      float wv[16];
#pragma unroll
      for (int reg = 0; reg < 16; ++reg) {
        int s = st * 32 + rowmap(reg, h);
        bool ok = d == 0 ? (s <= l) : (s >= l);
        float e = ok ? __expf(A_l - sAd[s]) * sDd[s] : 0.f;
        wv[reg] = X[st][reg] * e;
      }
#pragma unroll
      for (int sp = 0; sp < 2; ++sp) {
        bf16x8 bfrag = as_bf16x8(pack8(wv + sp * 8));
#pragma unroll
        for (int pt = 0; pt < 2; ++pt) {
          const u16* base = sXT + (pt * 32 + r) * ST + st * 32 + sp * 16 + 4 * h;
          uint2 lo = *(const uint2*)base, hi = *(const uint2*)(base + 8);
          uint4 ua; ua.x = lo.x; ua.y = lo.y; ua.z = hi.x; ua.w = hi.y;
          Y[pt] = mfma32(as_bf16x8(ua), bfrag, Y[pt]);
        }
      }
    }
  }
  u16* P = (u16*)(p.ws + OFF_P);
  const float dsk = p.ssd_d[layer * 8 + head];
  const int row = r0 + l;
  float ssq = 0.f;
  uint2 zpre[2][4];
#pragma unroll
  for (int pt = 0; pt < 2; ++pt)
#pragma unroll
    for (int q = 0; q < 4; ++q) zpre[pt][q] = *(const uint2*)(P + (size_t)row * PW + C_Z + head * 64 + pt * 32 + 8 * q + 4 * h);
#pragma unroll
  for (int pt = 0; pt < 2; ++pt)
#pragma unroll
    for (int q = 0; q < 4; ++q) {
      int p0 = pt * 32 + 8 * q + 4 * h;
      u16* zp = P + (size_t)row * PW + C_Z + head * 64 + p0;
      uint2 uz = zpre[pt][q];
      float z[4] = {bflo(uz.x), bfhi(uz.x), bflo(uz.y), bfhi(uz.y)};
      float gv[4];
#pragma unroll
      for (int i = 0; i < 4; ++i) {
        float xs = bf2f(sXT[(p0 + i) * ST + l]);
        float y = Y[pt][4 * q + i] + dsk * xs;
        gv[i] = y * silu_f(z[i]);
        ssq += gv[i] * gv[i];
      }
      uint2 uo; uo.x = pack2(gv[0], gv[1]); uo.y = pack2(gv[2], gv[3]);
      *(uint2*)zp = uo;
    }
  ssq += __shfl_xor(ssq, 32);
  if (h == 0) ((float*)(p.ws + OFF_SSQ))[(size_t)row * 8 + head] = ssq;
  __syncthreads();
}

DEV void attn_item(const Params& p, int b, int head, int qrow0, int nkeys, u16* outp, int ostride, char* smem) {
  u16* P = (u16*)(p.ws + OFF_P);
  const u16* VT = (const u16*)(p.ws + OFF_VT);
  const int t = tid(), lane = t & 63, w = t >> 6, r = lane & 31, h = lane >> 5;
  const int g = head >> 2;
  const u16* Kb = P + (size_t)(b * RB) * PW + C_K + g * 64;
  const u16* Vb = VT + (size_t)((b * 2 + g) * 64) * RB;
  u16* sQ = (u16*)smem + 4 * 64 * 72 + w * 64 * 72;
  {
    const u16* qsrc = P + (size_t)(qrow0 + w * 64) * PW + C_Q + head * 64;
#pragma unroll
    for (int i = 0; i < 8; ++i) {
      int idx = lane + 64 * i;
      *(uint4*)(sQ + (idx >> 3) * 72 + (idx & 7) * 8) = *(const uint4*)(qsrc + (size_t)(idx >> 3) * PW + (idx & 7) * 8);
    }
  }
  const u16* sQr = sQ + r * 72 + h * 8;
  f32x16 o[2][2];
  zero_acc<2>(o);
  float m[2] = {0.f, 0.f}, lsum[2] = {0.f, 0.f};
  u16* sbuf = (u16*)smem;
  const int c8 = (t & 7) * 8, ro = t >> 3;
  const u16* kp0 = Kb + (size_t)ro * PW + c8;
  const u16* vp0 = Vb + (size_t)ro * RB + c8;
  uint4 rk0 = *(const uint4*)(kp0), rk1 = *(const uint4*)(kp0 + (size_t)32 * PW);
  uint4 rv0 = *(const uint4*)(vp0), rv1 = *(const uint4*)(vp0 + (size_t)32 * RB);
  const int sofs = ro * 72 + c8;
  *(uint4*)(sbuf + sofs) = rk0;
  *(uint4*)(sbuf + sofs + 32 * 72) = rk1;
  *(uint4*)(sbuf + 64 * 72 + sofs) = rv0;
  *(uint4*)(sbuf + 64 * 72 + sofs + 32 * 72) = rv1;
  __syncthreads();
  const int ntile = nkeys >> 6;
  for (int kt = 0; kt < ntile; ++kt) {
    const bool more = kt + 1 < ntile;
    if (more) {
      int k0 = (kt + 1) << 6;
      rk0 = *(const uint4*)(kp0 + (size_t)k0 * PW);
      rk1 = *(const uint4*)(kp0 + (size_t)(k0 + 32) * PW);
      rv0 = *(const uint4*)(vp0 + k0);
      rv1 = *(const uint4*)(vp0 + (size_t)32 * RB + k0);
    }
    const u16* sK = sbuf + (kt & 1) * (128 * 72);
    const u16* sV = sK + 64 * 72;
    f32x16 s[2][2];
    const bool anym = __builtin_amdgcn_ballot_w64(m[0] != 0.f || m[1] != 0.f) != 0ull;
    if (anym) {
#pragma unroll
      for (int ks = 0; ks < 2; ++ks)
#pragma unroll
        for (int qs = 0; qs < 2; ++qs)
#pragma unroll
          for (int i = 0; i < 16; ++i) s[ks][qs][i] = -m[qs];
#pragma unroll
      for (int ks = 0; ks < 2; ++ks)
#pragma unroll
        for (int kk = 0; kk < 4; ++kk) {
          bf16x8 a = *(const bf16x8*)(sK + (ks * 32 + r) * 72 + kk * 16 + h * 8);
          bf16x8 q0 = *(const bf16x8*)(sQr + kk * 16);
          bf16x8 q1 = *(const bf16x8*)(sQr + 32 * 72 + kk * 16);
          s[ks][0] = mfma32(a, q0, s[ks][0]);
          s[ks][1] = mfma32(a, q1, s[ks][1]);
        }
    } else {
      const f32x16 zero16 = {0.f, 0.f, 0.f, 0.f, 0.f, 0.f, 0.f, 0.f, 0.f, 0.f, 0.f, 0.f, 0.f, 0.f, 0.f, 0.f};
#pragma unroll
      for (int ks = 0; ks < 2; ++ks)
#pragma unroll
        for (int kk = 0; kk < 4; ++kk) {
          bf16x8 a = *(const bf16x8*)(sK + (ks * 32 + r) * 72 + kk * 16 + h * 8);
          bf16x8 q0 = *(const bf16x8*)(sQr + kk * 16);
          bf16x8 q1 = *(const bf16x8*)(sQr + 32 * 72 + kk * 16);
          s[ks][0] = mfma32(a, q0, kk == 0 ? zero16 : s[ks][0]);
          s[ks][1] = mfma32(a, q1, kk == 0 ? zero16 : s[ks][1]);
        }
    }
    uint4 pf[2][2][2];
#pragma unroll
    for (int qs = 0; qs < 2; ++qs) {
      float rs = 0.f;
#pragma unroll
      for (int ks = 0; ks < 2; ++ks) {
        float pv[16];
#pragma unroll
        for (int i = 0; i < 16; ++i) { pv[i] = __builtin_amdgcn_exp2f(s[ks][qs][i]); rs += pv[i]; }
        pf[ks][0][qs] = pack8(pv);
        pf[ks][1][qs] = pack8(pv + 8);
      }
      if (__builtin_amdgcn_ballot_w64(!(rs < 1.0e9f)) != 0ull) {
        float mx = s[0][qs][0];
#pragma unroll
        for (int i = 1; i < 16; ++i) mx = fmaxf(mx, s[0][qs][i]);
#pragma unroll
        for (int i = 0; i < 16; ++i) mx = fmaxf(mx, s[1][qs][i]);
        mx = fmaxf(mx, __shfl_xor(mx, 32));
        const float d = fmaxf(mx - 8.f, 0.f);
        const float alpha = __builtin_amdgcn_exp2f(-d);
        m[qs] += d;
        lsum[qs] *= alpha;
#pragma unroll
        for (int i = 0; i < 16; ++i) { o[0][qs][i] *= alpha; o[1][qs][i] *= alpha; }
        rs = 0.f;
#pragma unroll
        for (int ks = 0; ks < 2; ++ks) {
          float pv[16];
#pragma unroll
          for (int i = 0; i < 16; ++i) { pv[i] = __builtin_amdgcn_exp2f(s[ks][qs][i] - d); rs += pv[i]; }
          pf[ks][0][qs] = pack8(pv);
          pf[ks][1][qs] = pack8(pv + 8);
        }
      }
      lsum[qs] += rs;
    }
#pragma unroll
    for (int ds = 0; ds < 2; ++ds)
#pragma unroll
      for (int ks = 0; ks < 2; ++ks)
#pragma unroll
        for (int sp = 0; sp < 2; ++sp) {
          bf16x8 a = *(const bf16x8*)(sV + (ds * 32 + r) * 72 + ks * 32 + sp * 16 + 8 * h);
          o[ds][0] = mfma32(a, as_bf16x8(pf[ks][sp][0]), o[ds][0]);
          o[ds][1] = mfma32(a, as_bf16x8(pf[ks][sp][1]), o[ds][1]);
        }
    if (more) {
      u16* nxt = sbuf + ((kt + 1) & 1) * (128 * 72);
      *(uint4*)(nxt + sofs) = rk0;
      *(uint4*)(nxt + sofs + 32 * 72) = rk1;
      *(uint4*)(nxt + 64 * 72 + sofs) = rv0;
      *(uint4*)(nxt + 64 * 72 + sofs + 32 * 72) = rv1;
    }
    __syncthreads();
  }
#pragma unroll
  for (int qs = 0; qs < 2; ++qs) {
    float lt = lsum[qs] + __shfl_xor(lsum[qs], 32);
    float inv = 1.f / lt;
    int row = qrow0 + w * 64 + qs * 32 + r;
#pragma unroll
    for (int ds = 0; ds < 2; ++ds)
#pragma unroll
      for (int q = 0; q < 4; ++q) {
        int d0 = ds * 32 + 8 * q + 4 * h;
        uint2 u; u.x = pack2(o[ds][qs][4 * q] * inv, o[ds][qs][4 * q + 1] * inv);
        u.y = pack2(o[ds][qs][4 * q + 2] * inv, o[ds][qs][4 * q + 3] * inv);
        *(uint2*)(outp + (size_t)row * ostride + head * 64 + d0) = u;
      }
  }
}

template <int MI, int NI>
DEV void merge_phase(const Params& p, int mode, char* smem) {
  const bool lat_only = mode == 1;
  u16* P = (u16*)(p.ws + OFF_P);
  const u16* H = (const u16*)(p.ws + OFF_H);
  const u16* WTI = (const u16*)(p.ws + OFF_WT_IN);
  const u16* WTB = (const u16*)(p.ws + OFF_WT_BR);
  const u16* PO = (const u16*)(p.ws + OFF_POOLED);
  const float* SSQ = (const float*)(p.ws + OFF_SSQ);
  const int x = bid() & 7, lb = bid() >> 3, nl = gridDim.x >> 3;
  int mt, nt;
  for (int j = lb;; j += nl) {
    if (mode == 3) {
      int tile = bid() + (j - lb) / nl * (int)gridDim.x;
      if (tile >= (512 / (64 * MI)) * (16 / NI)) break;
      mt = tile / (16 / NI); nt = tile % (16 / NI);
    } else if (!tile_map(j, x, 128, 16 / NI, mt, nt)) break;
    const int t = tid(), lane = t & 63, w = t >> 6, wr = w >> 1, wc = w & 1, r = lane & 31, h = lane >> 5;
    const int m0 = mode == 3 ? 16384 + mt * (64 * MI) : (lat_only ? (mt >> 6) * RB + 256 + (mt & 63) * 128 : mt * 128), n0 = nt * (64 * NI);
    f32x16 tot[MI][NI];
    zero_accm<MI, NI>(tot);
#pragma unroll 1
    for (int k = 0; k < 4; ++k) {
      unsigned gp[MI][NI][8];
      {
        f32x16 gacc[MI][NI];
        zero_accm<MI, NI>(gacc);
        int br = 4112 + k * 1024 + n0;
        gemm_core<MI, NI>(H, 1024, m0, R - 1, WTI, 1024, br, br + 64, 1024, gacc, smem);
#pragma unroll
        for (int a = 0; a < MI; ++a)
#pragma unroll
          for (int bq = 0; bq < NI; ++bq)
#pragma unroll
            for (int i = 0; i < 8; ++i) gp[a][bq][i] = pack2(sigmoid_f(gacc[a][bq][2 * i]), sigmoid_f(gacc[a][bq][2 * i + 1]));
      }
      f32x16 pacc[MI][NI];
      zero_accm<MI, NI>(pacc);
      const u16* A; int lda;
      if (k == 0) { A = P + C_Q; lda = PW; }
      else if (k == 1) { A = P + C_BG; lda = PW; }
      else if (k == 2) { A = PO; lda = 512; }
      else { A = P + C_Z; lda = PW; }
      gemm_core<MI, NI>(A, lda, m0, R - 1, WTB + (size_t)k * 1024 * 512, 512, n0, n0 + 64, 512, pacc, smem);
      if (k == 3) {
        const float* sb = SSQ + (size_t)m0 * 8;
#pragma unroll
        for (int mi = 0; mi < MI; ++mi)
#pragma unroll
          for (int reg = 0; reg < 16; ++reg) {
            unsigned off = (unsigned)(wr * (32 * MI) + 4 * h + mi * 32 + (reg & 3) + 8 * (reg >> 2)) * 8;
            const float4* sp = (const float4*)(sb + off);
            float4 s0 = sp[0], s1 = sp[1];
            float ss = s0.x + s0.y + s0.z + s0.w + s1.x + s1.y + s1.z + s1.w;
            float rstd = rsqrtf(ss * (1.f / 512.f) + 1e-6f);
#pragma unroll
            for (int bq = 0; bq < NI; ++bq) pacc[mi][bq][reg] *= rstd;
          }
      }
#pragma unroll
      for (int a = 0; a < MI; ++a)
#pragma unroll
        for (int bq = 0; bq < NI; ++bq)
#pragma unroll
          for (int i = 0; i < 8; ++i) {
            tot[a][bq][2 * i] += bflo(gp[a][bq][i]) * pacc[a][bq][2 * i];
            tot[a][bq][2 * i + 1] += bfhi(gp[a][bq][i]) * pacc[a][bq][2 * i + 1];
          }
    }
    u16* tb = P + (size_t)m0 * PW + C_YM + n0 + wc * (32 * NI);
#pragma unroll
    for (int mi = 0; mi < MI; ++mi)
#pragma unroll
      for (int reg = 0; reg < 16; ++reg) {
        unsigned off = (unsigned)(wr * (32 * MI) + 4 * h + mi * 32 + (reg & 3) + 8 * (reg >> 2)) * PW + r;
#pragma unroll
        for (int bq = 0; bq < NI; ++bq) tb[off + bq * 32] = f2bf(tot[mi][bq][reg]);
      }
  }
}

template <int MI>
DEV void resid_gemm_phase(const Params& p, int layer, int which, bool from_input, char* smem) {
  const u16* P = (const u16*)(p.ws + OFF_P);
  const float* mod = (const float*)(p.ws + OFF_MOD);
  const int x = bid() & 7, lb = bid() >> 3, nl = gridDim.x >> 3;
  int mt, nt;
  for (int j = lb; tile_map(j, x, MI == 4 ? 64 : 128, 8, mt, nt); j += nl) {
    const int t = tid(), lane = t & 63, w = t >> 6, wr = w >> 1, wc = w & 1, r = lane & 31, h = lane >> 5;
    const int m0 = MI == 4 ? (mt >> 5) * RB + 256 + (mt & 31) * 256 : mt * 128, n0 = nt * 128;
    f32x16 acc[MI][2];
    zero_accm<MI, 2>(acc);
    if (which == 0) gemm_core<MI, 2>(P + C_YM, PW, m0, R - 1, (const u16*)(p.ws + OFF_WT_OUT), 1024, n0, n0 + 64, 1024, acc, smem);
    else gemm_core<MI, 2>(P, 2816, m0, R - 1, (const u16*)(p.ws + OFF_WT_DOWN), 2816, n0, n0 + 64, 2816, acc, smem);
    const int cond = cond_of_row(m0);
    const float* gate = mod + (size_t)(layer * 3 + cond) * 6144 + (which == 0 ? 2048 : 5120) + n0 + wc * 64;
    const float* sb = (from_input ? xin_row(p, m0) : xres_row(p, m0)) + n0 + wc * 64;
    float* db = xres_row(p, m0) + n0 + wc * 64;
    const float gv0 = gate[r], gv1 = gate[32 + r];
#pragma unroll
    for (int mi = 0; mi < MI; ++mi) {
      float x0[16], x1[16];
      const float* sbm = sb + (size_t)(wr * (32 * MI) + 4 * h + mi * 32) * 1024 + r;
      float* dbm = db + (size_t)(wr * (32 * MI) + 4 * h + mi * 32) * 1024 + r;
#pragma unroll
      for (int reg = 0; reg < 16; ++reg) {
        unsigned off = (unsigned)((reg & 3) + 8 * (reg >> 2)) * 1024;
        x0[reg] = sbm[off]; x1[reg] = sbm[off + 32];
      }
      __builtin_amdgcn_sched_barrier(0);
#pragma unroll
      for (int reg = 0; reg < 16; ++reg) {
        unsigned off = (unsigned)((reg & 3) + 8 * (reg >> 2)) * 1024;
        dbm[off] = x0[reg] + gv0 * acc[mi][0][reg];
        dbm[off + 32] = x1[reg] + gv1 * acc[mi][1][reg];
      }
      __builtin_amdgcn_sched_barrier(0);
    }
  }
  if (MI == 2) {
    const int S = which == 0 ? 16 : 11, Ksub = which == 0 ? 64 : 256;
    for (int li = bid(); li < 32 * S; li += gridDim.x) {
      const int t = tid(), lane = t & 63, w = t >> 6, wr = w >> 1, wc = w & 1, r = lane & 31, h = lane >> 5;
      const int tile = li / S, ks = li - tile * S;
      const int m0 = (128 + (tile >> 3)) * 128, n0 = (tile & 7) * 128, koff = ks * Ksub;
      f32x16 acc[2][2];
      zero_accm<2, 2>(acc);
      if (which == 0) gemm_core<2, 2>(P + C_YM + koff, PW, m0, R - 1, (const u16*)(p.ws + OFF_WT_OUT) + koff, 1024, n0, n0 + 64, Ksub, acc, smem);
      else gemm_core<2, 2>(P + koff, 2816, m0, R - 1, (const u16*)(p.ws + OFF_WT_DOWN) + koff, 2816, n0, n0 + 64, Ksub, acc, smem);
      const float* gate = mod + (size_t)(layer * 3 + 1) * 6144 + (which == 0 ? 2048 : 5120) + n0 + wc * 64;
      float* db = xres_row(p, m0) + n0 + wc * 64;
      const float gv0 = gate[r], gv1 = gate[32 + r];
#pragma unroll
      for (int mi = 0; mi < 2; ++mi)
#pragma unroll
        for (int reg = 0; reg < 16; ++reg) {
          unsigned off = (unsigned)(wr * 64 + 4 * h + mi * 32 + (reg & 3) + 8 * (reg >> 2)) * 1024 + r;
          atomicAdd(db + off, gv0 * acc[mi][0][reg]);
          atomicAdd(db + off + 32, gv1 * acc[mi][1][reg]);
          if ((reg & 3) == 3) __builtin_amdgcn_sched_barrier(0);
        }
    }
  }
}

DEV void ffn_up_phase(const Params& p, int layer, char* smem) {
  constexpr int MI = 4, TR = 64 * MI, SS = 136;
  u16* ACT = (u16*)(p.ws + OFF_P);
  const u16* H = (const u16*)(p.ws + OFF_H);
  const u16* WT = (const u16*)(p.ws + OFF_WT_UP);
  const float* fc = p.ffn_conv + (size_t)layer * 3 * 5632;
  u16* stg = (u16*)smem;
  const int x = bid() & 7, lb = bid() >> 3, nl = gridDim.x >> 3;
  int mt, nt;
  for (int j = lb; tile_map(j, x, 67, 44, mt, nt); j += nl) {
    const int t = tid(), lane = t & 63, w = t >> 6, wr = w >> 1, wc = w & 1, r = lane & 31, h = lane >> 5;
    const int mrow0 = mt * (TR - 2) - 1;
    f32x16 acc[MI][2];
    zero_accm<MI, 2>(acc);
    gemm_core<MI, 2>(H, 1024, mrow0, R - 1, WT, 1024, nt * 64, 2816 + nt * 64, 1024, acc, smem);
#pragma unroll
    for (int mi = 0; mi < MI; ++mi)
#pragma unroll
      for (int ni = 0; ni < 2; ++ni)
#pragma unroll
        for (int reg = 0; reg < 16; ++reg)
          stg[(wr * (32 * MI) + mi * 32 + rowmap(reg, h)) * SS + wc * 64 + ni * 32 + r] = f2bf(acc[mi][ni][reg]);
    __syncthreads();
    {
      const int jc = (t & 31) * 2, rg = t >> 5;
      const int col = nt * 64 + jc;
      const float2 wg0 = *(const float2*)(fc + col), wg1 = *(const float2*)(fc + 5632 + col), wg2 = *(const float2*)(fc + 2 * 5632 + col);
      const float2 wv0 = *(const float2*)(fc + 2816 + col), wv1 = *(const float2*)(fc + 5632 + 2816 + col), wv2 = *(const float2*)(fc + 2 * 5632 + 2816 + col);
      int nit = (TR - 2 - (1 + rg)) / 8 + 1;
      { int lim = R - mrow0 - (1 + rg); int nv = lim <= 0 ? 0 : (lim + 7) / 8; nit = nit < nv ? nit : nv; }
#pragma unroll 4
      for (int q = 0; q < nit; ++q) {
        const int i = 1 + rg + 8 * q;
        int gr = mrow0 + i;
        int rr = gr % RB;
        bool first = (rr == 0) || (rr == 256), last = (rr == 255) || (rr == RB - 1);
        unsigned gm = first ? 0u : *(const unsigned*)(stg + (i - 1) * SS + jc), g0 = *(const unsigned*)(stg + i * SS + jc);
        unsigned gp = last ? 0u : *(const unsigned*)(stg + (i + 1) * SS + jc);
        unsigned vm = first ? 0u : *(const unsigned*)(stg + (i - 1) * SS + 64 + jc), v0 = *(const unsigned*)(stg + i * SS + 64 + jc);
        unsigned vp = last ? 0u : *(const unsigned*)(stg + (i + 1) * SS + 64 + jc);
        float cg0 = wg0.x * bflo(gm) + wg1.x * bflo(g0) + wg2.x * bflo(gp);
        float cg1 = wg0.y * bfhi(gm) + wg1.y * bfhi(g0) + wg2.y * bfhi(gp);
        float cv0 = wv0.x * bflo(vm) + wv1.x * bflo(v0) + wv2.x * bflo(vp);
        float cv1 = wv0.y * bfhi(vm) + wv1.y * bfhi(v0) + wv2.y * bfhi(vp);
        *(unsigned*)(ACT + (size_t)gr * 2816 + col) = pack2(silu_f(cg0) * cv0, silu_f(cg1) * cv1);
      }
    }
    __syncthreads();
  }
}

#define XB_TMO      128
#define XB_XCNT(j)  (256  + 64 * (j))
#define XB_XSUB(j)  (1280 + 64 * (j))
#define XB_XGEN(j)  (2304 + 64 * (j))
#define XB_TOP      3328
#define XB_TOPGEN   3392
#define XCD_BAR_WORDS 3456
#define XB_SPIN_CAP (1u << 18)
#define LAS __attribute__((address_space(3)))
DEV unsigned xb_ld(unsigned* p) { return __hip_atomic_load(p, __ATOMIC_RELAXED, __HIP_MEMORY_SCOPE_AGENT); }
DEV unsigned xb_add(unsigned* p, unsigned v) { return __hip_atomic_fetch_add(p, v, __ATOMIC_RELAXED, __HIP_MEMORY_SCOPE_AGENT); }
DEV unsigned xb_xcc_id() { return (unsigned)__builtin_amdgcn_s_getreg((3 << 11) | 20) & 0xFu; }
#define XB_SPIN(cond, bar) do { unsigned _sp = 0; while (cond) { __builtin_amdgcn_s_sleep(1); \
    if ((++_sp & 255u) == 0u) { if (xb_ld(&(bar)[XB_TMO])) break; if (_sp > XB_SPIN_CAP) { atomicAdd(&(bar)[XB_TMO], 1u); break; } } } } while (0)
struct XcdBarrier { unsigned* bar; unsigned x; volatile LAS unsigned* st; };
DEV XcdBarrier xcd_barrier_post(unsigned* bar, volatile LAS unsigned* st) {
  XcdBarrier b; b.bar = bar; b.x = xb_xcc_id(); b.st = st;
  if (__builtin_amdgcn_workitem_id_x() == 0) (void)xb_add(&bar[XB_XCNT(b.x)], 1u);
  return b;
}
DEV void xcd_barrier_complete(unsigned* bar, unsigned x, unsigned& nloc, unsigned& nx) {
  const unsigned G = gridDim.x * gridDim.y * gridDim.z;
  unsigned sum, cnt, mine, sp = 0u;
  for (;;) {
    sum = 0u; cnt = 0u; mine = 0u;
#pragma unroll
    for (unsigned j = 0; j < 16; ++j) { const unsigned c = xb_ld(&bar[XB_XCNT(j)]); sum += c; cnt += (c > 0u) ? 1u : 0u; mine = (j == x) ? c : mine; }
    if (sum == G) break;
    __builtin_amdgcn_s_sleep(1);
    if ((++sp & 255u) == 0u) { if (xb_ld(&bar[XB_TMO])) break; if (sp > XB_SPIN_CAP) { atomicAdd(&bar[XB_TMO], 1u); break; } }
  }
  nloc = mine > 0u ? mine : 1u; nx = cnt > 0u ? cnt : 1u;
}
DEV void xcd_barrier(const XcdBarrier& b) {
  asm volatile("s_waitcnt vmcnt(0)" ::: "memory");
  __syncthreads();
  if (__builtin_amdgcn_workitem_id_x() == 0) {
    unsigned* bar = b.bar;
    __builtin_amdgcn_s_waitcnt(0);
    unsigned nloc = b.st[0], nx = b.st[1];
    if (nloc == 0u) { xcd_barrier_complete(bar, b.x, nloc, nx); b.st[0] = nloc; b.st[1] = nx; }
    const unsigned old = xb_add(&bar[XB_XSUB(b.x)], 1u);
    const unsigned gen = old / nloc;
    if (old + 1u == (gen + 1u) * nloc) {
      __builtin_amdgcn_fence(__ATOMIC_RELEASE, "agent");
      asm volatile("s_waitcnt vmcnt(0)" ::: "memory");
      const unsigned og = xb_add(&bar[XB_TOP], 1u);
      const unsigned tg = og / nx;
      if (og + 1u == (tg + 1u) * nx) xb_add(&bar[XB_TOPGEN], 1u);
      else XB_SPIN(xb_ld(&bar[XB_TOPGEN]) == tg, bar);
      __builtin_amdgcn_fence(__ATOMIC_ACQUIRE, "agent");
      xb_add(&bar[XB_XGEN(b.x)], 1u);
      asm volatile("s_waitcnt vmcnt(0)" ::: "memory");
    } else {
      XB_SPIN(xb_ld(&bar[XB_XGEN(b.x)]) == gen, bar);
      __builtin_amdgcn_fence(__ATOMIC_ACQUIRE, "agent");
      asm volatile("s_waitcnt vmcnt(0)" ::: "memory");
    }
  }
  __syncthreads();
}

#ifndef PROBE
#define PROBE 0
#endif
DEV void run_phase(const Params& p, int ph, char* smem, bool dup) {
  if (ph == 0) {
    for (int it = bid(); it < 384; it += gridDim.x) mod_item(p, it, smem);
    {
      float* cosT = (float*)(p.ws + OFF_ROPE);
      float* sinT = cosT + 128 * 16;
      for (int i = bid() * NTHR + tid(); i < 2048; i += gridDim.x * NTHR) {
        int pos = i >> 4, f = i & 15;
        float inv = powf(10000.f, -(float)f / 16.f);
        float ang = (float)pos * inv;
        cosT[i] = cosf(ang); sinT[i] = sinf(ang);
      }
    }
    convert_weights(p, 0, 0, smem);
    return;
  }
  if (ph == 21) { norm_phase(p, 0, 2, false); return; }
  const int layer = (ph - 1) / 10, q = (ph - 1) % 10;
  switch (q) {
    case 0:
      norm_phase(p, layer, 0, layer == 0);
      break;
    case 1: inproj_phase(p, layer, smem); break;
    case 2: {
      const int n1 = 2 * 66 * 8, n2 = R / 4;
      for (int it = bid(); it < n1 + 2 * n2; it += gridDim.x) {
        if (it < n1) ssd1_item(p, layer, it, smem);
        else if (it < n1 + n2) pooled_item(p, it - n1);
        else if (!dup) sconv_item(p, layer, it - n1 - n2);
      }
    } break;
    case 3: ssd2_phase(p); if (!dup) convert_weights(p, layer, 1, smem); break;
    case 4: {
      const int na = layer == 0 ? 512 + 16 : 512, ns = 2 * 66 * 8;
#pragma unroll 1
      for (int it = bid(); it < na; it += gridDim.x) {
        int b, head, qrow0, nkeys;
        if (it < 512) {
          int xx = it & 7, jj = it >> 3;
          b = xx >> 2;
          int g = (xx >> 1) & 1, sub = (xx & 1) * 64 + jj;
          head = g * 4 + (sub >> 5);
          qrow0 = b * RB + 256 + (sub & 31) * 256; nkeys = RB;
        } else {
          int jj = it - 512;
          b = jj >> 3; head = jj & 7; qrow0 = b * RB; nkeys = 256;
        }
        if (dup) attn_item(p, b, head, qrow0, nkeys, (u16*)p.out, 512, smem);
        else attn_item(p, b, head, qrow0, nkeys, (u16*)(p.ws + OFF_P) + C_Q, PW, smem);
      }
      if (dup) break;
#pragma unroll 1
      for (int it = (bid() + gridDim.x - (na % gridDim.x)) % gridDim.x; it < ns; it += gridDim.x) {
        if (layer == 1 && ((it % (66 * 8)) >> 3) < 2) continue;
        ssd3_item(p, layer, it, smem);
      }
    } break;
    case 5: if (layer == 0) { merge_phase<2, 2>(p, 2, smem); merge_phase<1, 1>(p, 3, smem); } else merge_phase<2, 2>(p, 1, smem); break;
    case 6: if (layer == 0) resid_gemm_phase<2>(p, layer, 0, true, smem); else resid_gemm_phase<4>(p, layer, 0, false, smem); break;
    case 7: norm_phase(p, layer, 1, false); if (layer == 0 && !dup) convert_weights(p, 1, 0, smem); break;
    case 8: ffn_up_phase(p, layer, smem); break;
    case 9: if (layer == 0) resid_gemm_phase<2>(p, layer, 1, false, smem); else resid_gemm_phase<4>(p, layer, 1, false, smem); break;
  }
}

__global__ void __launch_bounds__(NTHR, 2) mega(Params p) {
  __shared__ __attribute__((aligned(16))) char smem[SMEM_BYTES];
  cg::grid_group grid = cg::this_grid();
  if (p.phase_lo < 0) grid.sync();
  uint4* xbw = (uint4*)(smem + SMEM_BYTES - 16);
  if (__builtin_amdgcn_workitem_id_x() == 0) *xbw = make_uint4(0u, 0u, 0u, 0u);
  __syncthreads();
  XcdBarrier xb = xcd_barrier_post((unsigned*)(p.ws + OFF_BAR), (volatile LAS unsigned*)xbw);
  for (int ph = p.phase_lo; ph < p.phase_hi; ++ph) {
    run_phase(p, ph, smem, false);
#if PROBE
    {
      const int q = ph >= 1 && ph <= 20 ? (ph - 1) % 10 : -1, layer = (ph - 1) / 10;
      bool m = false;
      if (PROBE == 1) m = q == 1;
      if (PROBE == 2) m = q == 4 && layer == 0;
      if (PROBE == 3) m = q == 5;
      if (PROBE == 4) m = q == 8;
      if (PROBE == 5) m = q == 7;
      if (PROBE == 6) m = q == 2;
      if (PROBE == 9) m = ph == 0;
      if (PROBE == 10) m = q == 6 && layer == 0;
      if (PROBE == 7) { if (q >= 0) { xcd_barrier(xb); xcd_barrier(xb); } }
      if (m) { xcd_barrier(xb); run_phase(p, ph, smem, true); }
    }
#endif
    if (ph + 1 < p.phase_hi) xcd_barrier(xb);
  }
}

extern "C" void kernel_launch(void* const* d_in, const int* in_sizes, int n_in, void* d_out, int out_size, void* d_ws,
                              size_t ws_size, hipStream_t stream) {
  static int grid_blocks = 0;
  if (!grid_blocks) {
    int dev = 0, cus = 0, per_cu = 0;
    hipGetDevice(&dev);
    hipDeviceGetAttribute(&cus, hipDeviceAttributeMultiprocessorCount, dev);
    hipOccupancyMaxActiveBlocksPerMultiprocessor(&per_cu, mega, NTHR, 0);
    if (per_cu > 2) per_cu = 2;
    if (per_cu < 1) per_cu = 1;
    grid_blocks = cus * per_cu;
    grid_blocks -= grid_blocks % 8;
    if (ws_size < WS_NEEDED) fprintf(stderr, "workspace too small: %zu < %zu\n", ws_size, (size_t)WS_NEEDED);
  }
  Params p{};
  const float** pp = (const float**)&p;
  for (int i = 0; i < 26; ++i) pp[i] = (const float*)d_in[i];
  p.out = (float*)d_out;
  p.ws = (char*)d_ws;
  p.phase_lo = 0;
  p.phase_hi = 22;
  (void)hipMemsetAsync((char*)d_ws + OFF_BAR, 0, XCD_BAR_WORDS * 4, stream);
  void* args[] = {&p};
  hipError_t e = hipLaunchCooperativeKernel((void*)mega, dim3(grid_blocks), dim3(NTHR), args, 0, stream);
  if (e != hipSuccess) fprintf(stderr, "cooperative launch failed: %s (grid %d)\n", hipGetErrorString(e), grid_blocks);
}
```
